# Optimizing an MI355X kernel written in HIP

```python
import math
import jax
import jax.numpy as jnp
from jax import lax
import numpy as np

D_MODEL = 1024
BATCH = 4
SEQ = 8192
DEPTH = 2

CTX_LEN = 256
GRID_W = 64
N_MOD = 9
EPS = 1e-6
NEG_INF = -1e30
HALF_STEP = 0.5
D_FF = 2816
FOURIER_GROUPS = 4
FOURIER_GW = D_MODEL // 8
D_FOURIER = FOURIER_GROUPS * FOURIER_GW
D_CONV = D_MODEL // 2
CONV_W = 31
EV_IN = D_FOURIER + 2 * D_CONV
EV_OUT = D_FOURIER + D_CONV
HEAD_DIM = 64
ROPE_BASE = 10000.0
H_DIFF = 4
DIFF_QK = H_DIFF * 2 * HEAD_DIM
DIFF_V = H_DIFF * 2 * HEAD_DIM
H_WIN = 8
H_WIN_KV = 2
WIN_G = H_WIN // H_WIN_KV
WIN_Q = H_WIN * HEAD_DIM
WIN_KV = H_WIN_KV * HEAD_DIM
WINDOW = 128
Q_BLOCK = 128
SPAN = Q_BLOCK + 2 * WINDOW
OD_SPLITS = (DIFF_QK, 2 * DIFF_QK, 2 * DIFF_QK + DIFF_V, 2 * DIFF_QK + DIFF_V + WIN_Q, 2 * DIFF_QK + DIFF_V + WIN_Q + WIN_KV)
OD_IN = 2 * DIFF_QK + DIFF_V + WIN_Q + 2 * WIN_KV
OD_OUT = DIFF_V + WIN_Q

kernel_name = 'hybrid_fourier_conv_diffattn_swa_flow_block'


def rms_norm(x, g):
    xf = x.astype(jnp.float32)
    y = xf * lax.rsqrt(jnp.mean(xf * xf, axis=-1, keepdims=True) + EPS)
    return (y * g.astype(jnp.float32)).astype(x.dtype)


def layer_norm(x, g, b):
    xf = x.astype(jnp.float32)
    xc = xf - jnp.mean(xf, axis=-1, keepdims=True)
    var = jnp.mean(xc * xc, axis=-1, keepdims=True)
    return (xc * lax.rsqrt(var + EPS) * g.astype(jnp.float32) + b.astype(jnp.float32)).astype(x.dtype)


def swiglu(h, w_in, w_out):
    gate, up = jnp.split(h @ w_in, 2, axis=-1)
    return (jax.nn.silu(gate) * up) @ w_out


def axial_rope_tables(rows):
    t = jnp.arange(rows * GRID_W)
    row = (t // GRID_W).astype(jnp.float32)
    col = (t % GRID_W).astype(jnp.float32)
    axis_dim = HEAD_DIM // 2
    inv_freq = ROPE_BASE ** (-jnp.arange(0, axis_dim, 2, dtype=jnp.float32) / axis_dim)
    ang_r = row[:, None] * inv_freq[None, :]
    ang_c = col[:, None] * inv_freq[None, :]
    return (jnp.cos(ang_r), jnp.sin(ang_r), jnp.cos(ang_c), jnp.sin(ang_c))


def _rotate(x, cos, sin):
    x1, x2 = jnp.split(x, 2, axis=-1)
    return jnp.concatenate([x1 * cos - x2 * sin, x2 * cos + x1 * sin], axis=-1)


def apply_axial_rope(x, rope):
    shp = (x.shape[1],) + (1,) * (x.ndim - 3) + (-1,)
    cr, sr, cc, sc = (t.reshape(shp).astype(x.dtype) for t in rope)
    xr, xc = jnp.split(x, 2, axis=-1)
    return jnp.concatenate([_rotate(xr, cr, sr), _rotate(xc, cc, sc)], axis=-1)


def fourier_conv_mix(h, w_in, conv_w, conv_b, ln_g, ln_b, w_out):
    B, L, _ = h.shape
    a, g = jnp.split(h @ w_in, [D_FOURIER], axis=-1)
    af = a.astype(jnp.float32).reshape(B, L, FOURIER_GROUPS, FOURIER_GW)
    fa = jnp.fft.fft2(af, axes=(1, 3), norm='ortho').real.astype(h.dtype).reshape(B, L, D_FOURIER)
    u = g[..., :D_CONV] * jax.nn.sigmoid(g[..., D_CONV:])
    u = lax.conv_general_dilated(u, conv_w[:, None, :], window_strides=(1,),
                                 padding=[(CONV_W // 2, CONV_W // 2)],
                                 dimension_numbers=('NWC', 'WIO', 'NWC'),
                                 feature_group_count=D_CONV) + conv_b
    u = jax.nn.silu(layer_norm(u, ln_g, ln_b))
    return jnp.concatenate([fa, u], axis=-1) @ w_out


def diff_attend(q1, q2, k1, k2, v, lam):
    scale = HEAD_DIM ** -0.5
    p1 = jax.nn.softmax(jnp.einsum('bhqd,bhkd->bhqk', q1, k1).astype(jnp.float32) * scale, axis=-1)
    p2 = jax.nn.softmax(jnp.einsum('bhqd,bhkd->bhqk', q2, k2).astype(jnp.float32) * scale, axis=-1)
    return jnp.einsum('bhqk,bhkd->bhqd', (p1 - lam * p2).astype(v.dtype), v)


def sink_attend(q, k_ctx, v_ctx, sink, k_win=None, v_win=None, mask=None):
    scale = HEAD_DIM ** -0.5
    B, Q = q.shape[:2]
    n_ctx = k_ctx.shape[1]
    parts = [jnp.broadcast_to(sink.astype(jnp.float32)[None, :, :, None, None], (B, H_WIN_KV, WIN_G, Q, 1)),
             jnp.einsum('bqhgd,bkhd->bhgqk', q, k_ctx).astype(jnp.float32) * scale]
    if k_win is not None:
        s_w = jnp.einsum('bqhgd,bkhd->bhgqk', q, k_win).astype(jnp.float32) * scale
        parts.append(jnp.where(mask, s_w, NEG_INF))
    p = jax.nn.softmax(jnp.concatenate(parts, axis=-1), axis=-1).astype(v_ctx.dtype)
    out = jnp.einsum('bhgqk,bkhd->bqhgd', p[..., 1:1 + n_ctx], v_ctx)
    if k_win is not None:
        out = out + jnp.einsum('bhgqk,bkhd->bqhgd', p[..., 1 + n_ctx:], v_win)
    return out


def diff_window_mix(hx, hc, w_in, lam_vec, subln_g, sink, w_out, lam_init, rope, ctx_out):
    B, S, _ = hx.shape
    C = hc.shape[1]
    nb = S // Q_BLOCK
    lv = lam_vec.astype(jnp.float32)
    lam = jnp.exp(jnp.sum(lv[0] * lv[1])) - jnp.exp(jnp.sum(lv[2] * lv[3])) + lam_init
    sink_g = sink.reshape(H_WIN_KV, WIN_G)

    def project(h):
        L = h.shape[1]
        dq, dk, dv, wq, wk, wv = jnp.split(h @ w_in, OD_SPLITS, axis=-1)
        return (dq.reshape(B, L, H_DIFF, 2, HEAD_DIM), dk.reshape(B, L, H_DIFF, 2, HEAD_DIM),
                dv.reshape(B, L, H_DIFF, 2 * HEAD_DIM), wq.reshape(B, L, H_WIN_KV, WIN_G, HEAD_DIM),
                wk.reshape(B, L, H_WIN_KV, HEAD_DIM), wv.reshape(B, L, H_WIN_KV, HEAD_DIM))

    dqx, dkx, dvx, wqx, wkx, wvx = project(hx)
    dqc, dkc, dvc, wqc, wkc, wvc = project(hc)
    dqx, dkx, wqx, wkx = (apply_axial_rope(t, rope) for t in (dqx, dkx, wqx, wkx))

    dk_all = jnp.concatenate([dkc, dkx], axis=1)
    k1 = dk_all[:, :, :, 0].transpose(0, 2, 1, 3)
    k2 = dk_all[:, :, :, 1].transpose(0, 2, 1, 3)
    v_all = jnp.concatenate([dvc, dvx], axis=1).transpose(0, 2, 1, 3)

    def to_blocks(q):
        return q.reshape(B, nb, Q_BLOCK, H_DIFF, HEAD_DIM).transpose(1, 0, 3, 2, 4)

    o = lax.map(lambda qs: diff_attend(qs[0], qs[1], k1, k2, v_all, lam),
                (to_blocks(dqx[:, :, :, 0]), to_blocks(dqx[:, :, :, 1])))
    o = o.transpose(1, 0, 3, 2, 4).reshape(B, S, H_DIFF, 2 * HEAD_DIM)
    diff_x = (rms_norm(o, subln_g) * (1.0 - lam_init)).reshape(B, S, DIFF_V)

    kp = jnp.pad(wkx, ((0, 0), (WINDOW, WINDOW), (0, 0), (0, 0)))
    vp = jnp.pad(wvx, ((0, 0), (WINDOW, WINDOW), (0, 0), (0, 0)))
    qb = jnp.moveaxis(wqx.reshape(B, nb, Q_BLOCK, H_WIN_KV, WIN_G, HEAD_DIM), 1, 0)
    offs_q = jnp.arange(Q_BLOCK)
    offs_k = jnp.arange(SPAN)

    def win_block(args):
        i, q = args
        start = i * Q_BLOCK
        kw = lax.dynamic_slice_in_dim(kp, start, SPAN, axis=1)
        vw = lax.dynamic_slice_in_dim(vp, start, SPAN, axis=1)
        qpos = start + offs_q
        kpos = start - WINDOW + offs_k
        mask = (jnp.abs(kpos[None, :] - qpos[:, None]) <= WINDOW) & (kpos >= 0)[None, :] & (kpos < S)[None, :]
        return sink_attend(q, wkc, wvc, sink_g, kw, vw, mask)

    wo = lax.map(win_block, (jnp.arange(nb), qb))
    win_x = jnp.moveaxis(wo, 0, 1).reshape(B, S, WIN_Q)
    yx = jnp.concatenate([diff_x, win_x], axis=-1) @ w_out
    if not ctx_out:
        return yx, None

    oc = diff_attend(dqc[:, :, :, 0].transpose(0, 2, 1, 3), dqc[:, :, :, 1].transpose(0, 2, 1, 3),
                     dkc[:, :, :, 0].transpose(0, 2, 1, 3), dkc[:, :, :, 1].transpose(0, 2, 1, 3),
                     dvc.transpose(0, 2, 1, 3), lam)
    diff_c = (rms_norm(oc.transpose(0, 2, 1, 3), subln_g) * (1.0 - lam_init)).reshape(B, C, DIFF_V)
    win_c = sink_attend(wqc, wkc, wvc, sink_g).reshape(B, C, WIN_Q)
    yc = jnp.concatenate([diff_c, win_c], axis=-1) @ w_out
    return yx, yc


def _pre(h, g, m, s):
    return rms_norm(h, g) * (1 + m[3 * s + 1]) + m[3 * s]


def _post(h, y, g, m, s, w):
    return h + w * m[3 * s + 2] * rms_norm(y, g)


def setup_inputs(seed: int = 0) -> dict:
    key = jax.random.key(seed)
    ks = jax.random.split(key, 21)
    n_even = (DEPTH + 1) // 2
    n_odd = DEPTH // 2
    D = D_MODEL

    def nrm(k, shape, scale):
        return jax.random.normal(k, shape, jnp.float32) * scale

    return {
        'x': nrm(ks[0], (BATCH, SEQ, D), 1.0),
        'c': nrm(ks[1], (BATCH, D), 1.0),
        'ctx': nrm(ks[2], (BATCH, CTX_LEN, D), 1.0),
        'c_ctx': nrm(ks[3], (D,), 1.0),
        'w_mod': nrm(ks[4], (DEPTH, D, N_MOD * D), 0.5 * D ** -0.5),
        'b_mod': nrm(ks[5], (DEPTH, N_MOD * D), 0.02),
        'norm_pre': 1.0 + nrm(ks[6], (DEPTH, 3, D), 0.05),
        'norm_post': 1.0 + nrm(ks[7], (DEPTH, 3, D), 0.05),
        'ffn_w_in': nrm(ks[8], (DEPTH, 2, D, 2 * D_FF), D ** -0.5),
        'ffn_w_out': nrm(ks[9], (DEPTH, 2, D_FF, D), D_FF ** -0.5),
        'ev_w_in': nrm(ks[10], (n_even, D, EV_IN), D ** -0.5),
        'ev_conv_w': nrm(ks[11], (n_even, CONV_W, D_CONV), CONV_W ** -0.5),
        'ev_conv_b': nrm(ks[12], (n_even, D_CONV), 0.02),
        'ev_ln_g': 1.0 + nrm(ks[13], (n_even, D_CONV), 0.05),
        'ev_ln_b': nrm(ks[14], (n_even, D_CONV), 0.02),
        'ev_w_out': nrm(ks[15], (n_even, EV_OUT, D), EV_OUT ** -0.5),
        'od_w_in': nrm(ks[16], (n_odd, D, OD_IN), D ** -0.5),
        'od_lambda': nrm(ks[17], (n_odd, 4, HEAD_DIM), 0.1),
        'od_subln_g': 1.0 + nrm(ks[18], (n_odd, 2 * HEAD_DIM), 0.05),
        'od_sink': nrm(ks[19], (n_odd, H_WIN), 0.5),
        'od_w_out': nrm(ks[20], (n_odd, OD_OUT, D), OD_OUT ** -0.5),
    }


def reference(x, c, ctx, c_ctx, w_mod, b_mod, norm_pre, norm_post, ffn_w_in, ffn_w_out,
              ev_w_in, ev_conv_w, ev_conv_b, ev_ln_g, ev_ln_b, ev_w_out,
              od_w_in, od_lambda, od_subln_g, od_sink, od_w_out):
    B, n_tok, D = x.shape
    rows = n_tok // GRID_W
    rope = axial_rope_tables(rows)
    for l in range(DEPTH):
        last = l == DEPTH - 1
        odd = l % 2 == 1
        ctx_in = (not last) or odd
        ctx_out = not last
        mx = (jax.nn.silu(c) @ w_mod[l] + b_mod[l]).reshape(B, N_MOD, D).transpose(1, 0, 2)[:, :, None, :]
        mc = (jax.nn.silu(c_ctx) @ w_mod[l] + b_mod[l]).reshape(N_MOD, 1, 1, D)
        x = _post(x, swiglu(_pre(x, norm_pre[l, 0], mx, 0), ffn_w_in[l, 0], ffn_w_out[l, 0]),
                  norm_post[l, 0], mx, 0, HALF_STEP)
        if ctx_in:
            ctx = _post(ctx, swiglu(_pre(ctx, norm_pre[l, 0], mc, 0), ffn_w_in[l, 0], ffn_w_out[l, 0]),
                        norm_post[l, 0], mc, 0, HALF_STEP)
        hx = _pre(x, norm_pre[l, 1], mx, 1)
        j = l // 2
        if odd:
            hc = _pre(ctx, norm_pre[l, 1], mc, 1)
            lam_init = 0.8 - 0.6 * math.exp(-0.3 * l)
            yx, yc = diff_window_mix(hx, hc, od_w_in[j], od_lambda[j], od_subln_g[j], od_sink[j],
                                     od_w_out[j], lam_init, rope, ctx_out)
        else:
            yx = fourier_conv_mix(hx, ev_w_in[j], ev_conv_w[j], ev_conv_b[j], ev_ln_g[j], ev_ln_b[j], ev_w_out[j])
            yc = None
            if ctx_out:
                hc = _pre(ctx, norm_pre[l, 1], mc, 1)
                yc = fourier_conv_mix(hc, ev_w_in[j], ev_conv_w[j], ev_conv_b[j], ev_ln_g[j], ev_ln_b[j], ev_w_out[j])
        x = _post(x, yx, norm_post[l, 1], mx, 1, 1.0)
        if ctx_out:
            ctx = _post(ctx, yc, norm_post[l, 1], mc, 1, 1.0)
        x = _post(x, swiglu(_pre(x, norm_pre[l, 2], mx, 2), ffn_w_in[l, 1], ffn_w_out[l, 1]),
                  norm_post[l, 2], mx, 2, HALF_STEP)
        if ctx_out:
            ctx = _post(ctx, swiglu(_pre(ctx, norm_pre[l, 2], mc, 2), ffn_w_in[l, 1], ffn_w_out[l, 1]),
                        norm_post[l, 2], mc, 2, HALF_STEP)
    return x
```

```cpp
#include <hip/hip_runtime.h>
#include <hip/hip_cooperative_groups.h>
#include <cstdio>
#include <cstdint>
namespace cg = cooperative_groups;
namespace pg8 {
#define PG8_LAS __attribute__((address_space(3)))
typedef unsigned short bf16_t;
typedef short bf16x8 __attribute__((ext_vector_type(8)));
typedef float f32x4 __attribute__((ext_vector_type(4)));
typedef unsigned u32x4 __attribute__((ext_vector_type(4)));
constexpr int BM = 256, BK = 64, HALF = 128, HTB = HALF * BK * 2  , STAGE_BYTES = 8 * HTB, NXCD = 8, WGM = 8;

__host__ __device__ __forceinline__ int lds_byte(int r, int c) { const int st = (r >> 4) * 2 + (c >> 5), rr = r & 15, cc = c & 31, ob = rr * 64 + cc * 2; return st * 1024 + (ob ^ (((ob >> 9) & 1) << 5)); }
__host__ __device__ __forceinline__ void stage_rc(int b, int& R, int& C) { const int st = b / 1024, sb = b % 1024, swz = sb ^ (((sb >> 9) & 1) << 5); R = (st >> 1) * 16 + swz / 64; C = (st & 1) * 32 + (swz % 64) / 2; }
__host__ __device__ __forceinline__ int perm32(int rho) { const int n = rho >> 4, i = rho & 15; return 8 * (i >> 2) + 4 * n + (i & 3); }

struct Unit { int pm, pn, ks; };
struct Gemm { const bf16_t* A; const bf16_t* Bt; int M, N, K, ld; };

struct StaticOrder {
    int nM, nN, nwg, G, c;
    __host__ __device__ void init(int M, int N, int G_, int c_) { nM = M / BM; nN = N / BM; nwg = nM * nN; G = G_; c = c_; }
    __host__ __device__ bool next(int i, Unit& u) const {
        const long L = (long)i * G + c; if (L >= nwg) return false;
        int wgid = (int)L; { const int q = nwg / NXCD, r = nwg % NXCD, xcd = wgid % NXCD, off = wgid / NXCD; wgid = (xcd < r ? xcd * (q + 1) : r * (q + 1) + (xcd - r) * q) + off; }
        const int nig = WGM * nN, gid = wgid / nig, fm = gid * WGM, gsz = (nM - fm) < WGM ? (nM - fm) : WGM;
        u.pm = fm + ((wgid % nig) % gsz); u.pn = (wgid % nig) / gsz; u.ks = 0; return true;
    }
    __device__ __forceinline__ void a_ready(const Unit&) const {}
    __device__ __forceinline__ void done(const Unit&) const {}
};
}
#define LAS __attribute__((address_space(3)))
#define GAS __attribute__((address_space(1)))
#define DI __device__ __forceinline__
typedef unsigned short bf16;
typedef unsigned char uchar;
typedef float f32x2_t __attribute__((ext_vector_type(2)));
typedef __bf16 bf16x2_t __attribute__((ext_vector_type(2)));
typedef float f32x4 __attribute__((ext_vector_type(4)));
typedef float f32x16 __attribute__((ext_vector_type(16)));
typedef unsigned u32x2 __attribute__((ext_vector_type(2)));
typedef unsigned u32x4 __attribute__((ext_vector_type(4)));
typedef short bf16x8 __attribute__((ext_vector_type(8)));
typedef short s16x4 __attribute__((ext_vector_type(4)));
#define MFMA32(a, b, c) __builtin_amdgcn_mfma_f32_32x32x16_bf16((a), (b), (c), 0, 0, 0)

DI unsigned pk2(float lo, float hi) { f32x2_t v = {lo, hi}; bf16x2_t b = __builtin_convertvector(v, bf16x2_t); return __builtin_bit_cast(unsigned, b); }
DI float bflo(unsigned w) { return __uint_as_float(w << 16); }
DI float bfhi(unsigned w) { return __uint_as_float(w & 0xffff0000u); }
DI float wave_sum(float v) {
#pragma unroll
    for (int o = 1; o < 64; o <<= 1) v += __shfl_xor(v, o);
    return v;
}
DI float sigm(float x) { return __builtin_amdgcn_rcpf(1.0f + __builtin_amdgcn_exp2f(-1.4426950408889634f * x)); }
DI float silu(float x) { return x * sigm(x); }

constexpr int DM = 1024, NB = 4, SEQ = 8192, CTX = 256, DFF = 2816;
constexpr int MX = NB * SEQ;
constexpr int MC = NB * CTX;
constexpr int MT = MX + MC;
constexpr int KV = CTX + SEQ;
constexpr float EPS = 1e-6f;
constexpr float LOG2E = 1.4426950408889634f;
constexpr float LAM_INIT = 0.35550906759096926f;

constexpr size_t MiB = 1u << 20;
constexpr size_t WS_MODP = 10 * MiB  , WS_MOD = 4 * MiB, WS_ROPE = 5 * MiB, WS_COST = 5 * MiB + 65536, WS_NSIN = 5 * MiB + 2 * 65536, WS_CTXR = 6 * MiB;
constexpr size_t WS_W1T = 16 * MiB, WS_W2T = 60 * MiB, WS_WEVIN = 82 * MiB, WS_WEVOUT = 86 * MiB, WS_WODIN = 88 * MiB, WS_WODOUT = 93 * MiB, WS_DFTC = 95 * MiB;
constexpr size_t WS_H = 96 * MiB, WS_Y = 162 * MiB, WS_BIG = 228 * MiB;
constexpr size_t WS_ACT = WS_BIG;
constexpr size_t WS_PQ = WS_BIG, WS_UG = 294 * MiB, WS_BDFT = 327 * MiB, WS_BDFTC = 359 * MiB, WS_DFTM = 360 * MiB;
constexpr size_t WS_DS = 424 * MiB;
constexpr size_t WS_QD = WS_BIG, WS_QW = 260 * MiB, WS_DK = 292 * MiB, WS_DVT = 325 * MiB, WS_WK = 358 * MiB, WS_WVT = 367 * MiB;
constexpr size_t WS_XF = 410 * MiB;
constexpr size_t WS_YS = 488 * MiB;
constexpr size_t WS_END = 510 * MiB;
constexpr size_t W1T_SZ = (size_t)2 * DFF * DM, W2T_SZ = (size_t)DM * DFF;

constexpr int LDS_BYTES = 147456;

struct Args { const float* in[21]; float* out; unsigned char* ws; int ph_lo, ph_hi; };
enum { I_X = 0, I_C, I_CTX, I_CCTX, I_WMOD, I_BMOD, I_NPRE, I_NPOST, I_FWIN, I_FWOUT, I_EVWIN, I_EVCW, I_EVCB, I_EVLNG, I_EVLNB, I_EVWOUT, I_ODWIN, I_ODLAM, I_ODSUBG, I_ODSINK, I_ODWOUT };

namespace pg8 {
struct EpiY {
    static constexpr bool PERM = true, AFTER_DRAIN = false;
    GAS bf16_t* O; int ldc; float sc; int dft; int L; int rowbase; int slab;
    __device__ __forceinline__ void operator()(const f32x4 (&acc)[2][2][4][2], const Unit& u, int wr, int wc, int fr, int fq) const {
        const int row0 = u.pm * BM + wr * 64 + fr;
        GAS bf16_t* base; int colt;
        if (dft) { base = O + (size_t)(rowbase + (u.pn >> 1) * L) * ldc + (u.pn & 1) * 256; colt = 0; } else { base = O + (size_t)u.ks * slab; colt = u.pn * BM; }
        const int col0 = colt + wc * 32 + 8 * fq;
#pragma unroll
        for (int ai = 0; ai < 2; ++ai)
#pragma unroll
            for (int m = 0; m < 4; ++m) { GAS bf16_t* rowp = base + (size_t)(row0 + ai * HALF + m * 16) * ldc + col0;
#pragma unroll
                for (int bj = 0; bj < 2; ++bj) { const f32x4 v0 = acc[ai][bj][m][0] * sc, v1 = acc[ai][bj][m][1] * sc;
                    u32x4 w; w.x = pk2(v0[0], v0[1]); w.y = pk2(v0[2], v0[3]); w.z = pk2(v1[0], v1[1]); w.w = pk2(v1[2], v1[3]);
                    *(GAS u32x4*)(rowp + bj * HALF) = w; } }
    }
};
struct EpiSwiGLU {
    static constexpr bool PERM = true, AFTER_DRAIN = false;
    GAS bf16_t* O;
    __device__ __forceinline__ void operator()(const f32x4 (&acc)[2][2][4][2], const Unit& u, int wr, int wc, int fr, int fq) const {
        const int row0 = u.pm * BM + wr * 64 + fr, col0 = u.pn * HALF + wc * 32 + 8 * fq;
#pragma unroll
        for (int ai = 0; ai < 2; ++ai)
#pragma unroll
            for (int m = 0; m < 4; ++m) { GAS bf16_t* rowp = O + (size_t)(row0 + ai * HALF + m * 16) * DFF + col0;
                const f32x4 g0 = acc[ai][0][m][0], g1 = acc[ai][0][m][1], u0 = acc[ai][1][m][0], u1 = acc[ai][1][m][1];
                u32x4 w; w.x = pk2(silu(g0[0]) * u0[0], silu(g0[1]) * u0[1]); w.y = pk2(silu(g0[2]) * u0[2], silu(g0[3]) * u0[3]);
                w.z = pk2(silu(g1[0]) * u1[0], silu(g1[1]) * u1[1]); w.w = pk2(silu(g1[2]) * u1[2], silu(g1[3]) * u1[3]);
                *(GAS u32x4*)rowp = w; }
    }
};
struct EpiEvIn {
    static constexpr bool PERM = true, AFTER_DRAIN = false;
    GAS bf16_t* PQ; GAS bf16_t* UG;
    __device__ __forceinline__ void operator()(const f32x4 (&acc)[2][2][4][2], const Unit& u, int wr, int wc, int fr, int fq) const {
        const int row0 = u.pm * BM + wr * 64 + fr;
        if (u.pn < 4) {
            const int col0 = u.pn * BM + wc * 32 + 8 * fq;
#pragma unroll
            for (int ai = 0; ai < 2; ++ai)
#pragma unroll
                for (int m = 0; m < 4; ++m) { GAS bf16_t* rowp = PQ + (size_t)(row0 + ai * HALF + m * 16) * 1024 + col0;
#pragma unroll
                    for (int bj = 0; bj < 2; ++bj) { const f32x4 v0 = acc[ai][bj][m][0], v1 = acc[ai][bj][m][1];
                        u32x4 w; w.x = pk2(v0[0], v0[1]); w.y = pk2(v0[2], v0[3]); w.z = pk2(v1[0], v1[1]); w.w = pk2(v1[2], v1[3]);
                        *(GAS u32x4*)(rowp + bj * HALF) = w; } }
        } else {
            const int col0 = (u.pn - 4) * HALF + wc * 32 + 8 * fq;
#pragma unroll
            for (int ai = 0; ai < 2; ++ai)
#pragma unroll
                for (int m = 0; m < 4; ++m) { GAS bf16_t* rowp = UG + (size_t)(row0 + ai * HALF + m * 16) * 512 + col0;
                    const f32x4 a0 = acc[ai][0][m][0], a1 = acc[ai][0][m][1], g0 = acc[ai][1][m][0], g1 = acc[ai][1][m][1];
                    u32x4 w; w.x = pk2(a0[0] * sigm(g0[0]), a0[1] * sigm(g0[1])); w.y = pk2(a0[2] * sigm(g0[2]), a0[3] * sigm(g0[3]));
                    w.z = pk2(a1[0] * sigm(g1[0]), a1[1] * sigm(g1[1])); w.w = pk2(a1[2] * sigm(g1[2]), a1[3] * sigm(g1[3]));
                    *(GAS u32x4*)rowp = w; }
        }
    }
};
struct EpiOdIn {
    static constexpr bool PERM = false, AFTER_DRAIN = false;
    GAS bf16_t *QD, *QW, *DK, *DVT, *WK, *WVT; const GAS f32x2_t* rope;
    __device__ __forceinline__ void operator()(const f32x4 (&acc)[2][2][4][2], const Unit& u, int wr, int wc, int fr, int fq) const {
        const bool isx = (u.pm * BM) < MX;
        const int axis = wc & 1;
#pragma unroll
        for (int ai = 0; ai < 2; ++ai)
#pragma unroll
            for (int m = 0; m < 4; ++m) {
                const int r = u.pm * BM + ai * HALF + wr * 64 + m * 16 + fr;
                int b, p, t;
                if (isx) { b = r >> 13; t = r & 8191; p = CTX + t; } else { b = (r - MX) >> 8; t = 0; p = (r - MX) & 255; }
                f32x4 cs0 = {1.f, 0.f, 1.f, 0.f}, cs1 = {1.f, 0.f, 1.f, 0.f};
                if (isx) { const int pidx = axis ? (t & 63) : (t >> 6); const GAS f32x4* rp = (const GAS f32x4*)(rope + pidx * 16 + 4 * fq); cs0 = rp[0]; cs1 = rp[1]; }
                const size_t kvrow = (size_t)b * KV + p;
                const int pp = (p & ~12) | ((p & 4) << 1) | ((p & 8) >> 1);
#pragma unroll
                for (int bj = 0; bj < 2; ++bj) {
                    const int cb = u.pn * BM + bj * HALF + wc * 32;
                    f32x4 v0 = acc[ai][bj][m][0], v1 = acc[ai][bj][m][1];
                    const bool roped = (cb < 1024) || (cb >= 1536 && cb < 2176);
                    if (roped && isx) {
                        f32x4 o0, o1;
                        o0[0] = v0[0] * cs0[0] - v1[0] * cs0[1]; o1[0] = v1[0] * cs0[0] + v0[0] * cs0[1];
                        o0[1] = v0[1] * cs0[2] - v1[1] * cs0[3]; o1[1] = v1[1] * cs0[2] + v0[1] * cs0[3];
                        o0[2] = v0[2] * cs1[0] - v1[2] * cs1[1]; o1[2] = v1[2] * cs1[0] + v0[2] * cs1[1];
                        o0[3] = v0[3] * cs1[2] - v1[3] * cs1[3]; o1[3] = v1[3] * cs1[2] + v0[3] * cs1[3];
                        v0 = o0; v1 = o1;
                    }
                    if (cb < 512 || (cb >= 1536 && cb < 2048)) { v0 = v0 * (0.125f * LOG2E); v1 = v1 * (0.125f * LOG2E); }
                    u32x2 w0, w1; w0.x = pk2(v0[0], v0[1]); w0.y = pk2(v0[2], v0[3]); w1.x = pk2(v1[0], v1[1]); w1.y = pk2(v1[2], v1[3]);
                    if (cb < 512) { if (isx) { GAS bf16_t* d = QD + (size_t)r * 512 + cb + 4 * fq; *(GAS u32x2*)d = w0; *(GAS u32x2*)(d + 16) = w1; } }
                    else if (cb < 1024) { GAS bf16_t* d = DK + kvrow * 512 + (cb - 512) + 4 * fq; *(GAS u32x2*)d = w0; *(GAS u32x2*)(d + 16) = w1; }
                    else if (cb < 1536) { GAS bf16_t* d = DVT + ((size_t)b * 512 + (cb - 1024) + 4 * fq) * KV + pp;
                        d[0] = (bf16_t)(w0.x & 0xffff); d[KV] = (bf16_t)(w0.x >> 16); d[2 * KV] = (bf16_t)(w0.y & 0xffff); d[3 * KV] = (bf16_t)(w0.y >> 16);
                        d += (size_t)16 * KV;
                        d[0] = (bf16_t)(w1.x & 0xffff); d[KV] = (bf16_t)(w1.x >> 16); d[2 * KV] = (bf16_t)(w1.y & 0xffff); d[3 * KV] = (bf16_t)(w1.y >> 16); }
                    else if (cb < 2048) { if (isx) { GAS bf16_t* d = QW + (size_t)r * 512 + (cb - 1536) + 4 * fq; *(GAS u32x2*)d = w0; *(GAS u32x2*)(d + 16) = w1; } }
                    else if (cb < 2176) { GAS bf16_t* d = WK + kvrow * 128 + (cb - 2048) + 4 * fq; *(GAS u32x2*)d = w0; *(GAS u32x2*)(d + 16) = w1; }
                    else { GAS bf16_t* d = WVT + ((size_t)b * 128 + (cb - 2176) + 4 * fq) * KV + pp;
                        d[0] = (bf16_t)(w0.x & 0xffff); d[KV] = (bf16_t)(w0.x >> 16); d[2 * KV] = (bf16_t)(w0.y & 0xffff); d[3 * KV] = (bf16_t)(w0.y >> 16);
                        d += (size_t)16 * KV;
                        d[0] = (bf16_t)(w1.x & 0xffff); d[KV] = (bf16_t)(w1.x >> 16); d[2 * KV] = (bf16_t)(w1.y & 0xffff); d[3 * KV] = (bf16_t)(w1.y >> 16); }
                }
            }
    }
};
}
namespace pg8 {
template <class Epi, class Sched, bool ALIGN_EPI = false, bool SP2 = false>
__device__ __forceinline__ void gemm_phase(PG8_LAS unsigned char* lds, const Gemm g, const Sched& S, const Epi& E) {
    int tid_ = threadIdx.x; asm volatile("" : "+v"(tid_));
    const int tid = tid_, wid = __builtin_amdgcn_readfirstlane(tid >> 6), lane = tid & 63, wr = wid >> 2, wc = wid & 3, fr = lane & 15, fq = lane >> 4;
    const int K = g.K, nt = K / BK;
    unsigned voffA[2], voffB[2];
#pragma unroll
    for (int i = 0; i < 2; ++i) { int R, C; stage_rc(tid * 16 + i * 8192, R, C); const int Rb = Epi::PERM ? ((R & ~31) + perm32(R & 31)) : R;
        voffA[i] = (unsigned)(R * g.ld + C) * 2u; voffB[i] = (unsigned)(Rb * g.ld + C) * 2u; }
    const size_t kstep = (size_t)(BK * 2);
    const size_t hstep = (size_t)HALF * g.ld * 2;
    const size_t tstep = 2 * hstep;
    const unsigned ldsw = (unsigned)wid * 1024u;
    const int aoff = lds_byte(wr * 64 + fr, fq * 8), boff = lds_byte(wc * 32 + fr, fq * 8);
#define PG8_SA(b, h) (((b) * 2 + (h)) * HTB)
#define PG8_SB(b, h) ((4 + (b) * 2 + (h)) * HTB)
#define PG8_STAGE(bufoff, gbase, voff) do { _Pragma("unroll") for (int _i = 0; _i < 2; ++_i) \
        __builtin_amdgcn_global_load_lds((const unsigned*)((const char*)(gbase) + (voff)[_i]), (PG8_LAS unsigned*)(lds + (bufoff) + ldsw + _i * 8192), 16, 0, 0); } while (0)
#define PG8_LDA(dst, b, h) do { _Pragma("unroll") for (int m = 0; m < 4; ++m) _Pragma("unroll") for (int k = 0; k < 2; ++k) dst[m][k] = *(const PG8_LAS bf16x8*)(lds + PG8_SA(b, h) + aoff + m * 2048 + k * 1024); } while (0)
#define PG8_LDB(dst, b, h) do { _Pragma("unroll") for (int n = 0; n < 2; ++n) _Pragma("unroll") for (int k = 0; k < 2; ++k) dst[n][k] = *(const PG8_LAS bf16x8*)(lds + PG8_SB(b, h) + boff + n * 2048 + k * 1024); } while (0)
#define PG8_MMA(ai, bj, At, Bt) do { __builtin_amdgcn_s_setprio(1); _Pragma("unroll") for (int m = 0; m < 4; ++m) _Pragma("unroll") for (int n = 0; n < 2; ++n) _Pragma("unroll") for (int k = 0; k < 2; ++k) \
        acc[ai][bj][m][n] = __builtin_amdgcn_mfma_f32_16x16x32_bf16(Bt[n][k], At[m][k], acc[ai][bj][m][n], 0, 0, 0); __builtin_amdgcn_s_setprio(0); } while (0)
#define PG8_WAIT_V(n) asm volatile("s_waitcnt vmcnt(" #n ")" ::: "memory")
#define PG8_WAIT_L(n) asm volatile("s_waitcnt lgkmcnt(" #n ")" ::: "memory")
#define PG8_BAR __builtin_amdgcn_s_barrier()
#define PG8_SCHED __builtin_amdgcn_sched_barrier(0)
    Unit cur, nxt; int ui = 0;
    if (!S.next(0, cur)) return;
    f32x4 acc[2][2][4][2];
#pragma unroll
    for (int a = 0; a < 2; ++a)
#pragma unroll
        for (int b = 0; b < 2; ++b)
#pragma unroll
            for (int m = 0; m < 4; ++m)
#pragma unroll
                for (int n = 0; n < 2; ++n) acc[a][b][m][n] = (f32x4){0.f, 0.f, 0.f, 0.f};
    bf16x8 At[4][2], B0[2][2], B1[2][2];
    const char* cA = (const char*)g.A + (size_t)cur.pm * tstep + (size_t)cur.ks * K * 2; const char* cB = (const char*)g.Bt + (size_t)cur.pn * tstep + (size_t)cur.ks * K * 2;
    S.a_ready(cur);
    if constexpr (SP2) {
        PG8_STAGE(PG8_SB(0, 0), cB, voffB); PG8_STAGE(PG8_SB(0, 1), cB + hstep, voffB); PG8_STAGE(PG8_SA(0, 0), cA, voffA); PG8_STAGE(PG8_SA(0, 1), cA + hstep, voffA);
        if (wr == 1) PG8_BAR;
        PG8_WAIT_V(2); PG8_BAR;
        PG8_STAGE(PG8_SB(1, 0), cB + kstep, voffB); PG8_STAGE(PG8_SA(1, 0), cA + kstep, voffA); PG8_STAGE(PG8_SB(1, 1), cB + hstep + kstep, voffB);
        PG8_WAIT_V(6); PG8_BAR;
    } else {
        PG8_STAGE(PG8_SB(0, 0), cB, voffB); PG8_STAGE(PG8_SA(0, 0), cA, voffA); PG8_STAGE(PG8_SB(0, 1), cB + hstep, voffB); PG8_STAGE(PG8_SA(0, 1), cA + hstep, voffA);
        if (wr == 1) PG8_BAR;
        PG8_WAIT_V(4); PG8_BAR;
        PG8_STAGE(PG8_SB(1, 0), cB + kstep, voffB); PG8_STAGE(PG8_SA(1, 0), cA + kstep, voffA); PG8_STAGE(PG8_SB(1, 1), cB + hstep + kstep, voffB);
        PG8_WAIT_V(6); PG8_BAR;
    }
    for (;;) {
        const bool has_next = S.next(ui + 1, nxt);
        const char* nA = has_next ? (const char*)g.A + (size_t)nxt.pm * tstep + (size_t)nxt.ks * K * 2 : cA; const char* nB = has_next ? (const char*)g.Bt + (size_t)nxt.pn * tstep + (size_t)nxt.ks * K * 2 : cB;
        for (int t = 0; t < nt; t += 2) {
            const bool last = (t == nt - 2);
            const char* a1 = cA + (size_t)(t + 1) * kstep;
            const char* a2 = last ? nA : cA + (size_t)(t + 2) * kstep; const char* b2 = last ? nB : cB + (size_t)(t + 2) * kstep;
            const char* a3 = a2 + kstep; const char* b3 = b2 + kstep;
            if (last && has_next) S.a_ready(nxt);
            if constexpr (SP2) {
            PG8_LDB(B0, 0, 0); PG8_LDB(B1, 0, 1); PG8_SCHED; PG8_LDA(At, 0, 0); PG8_STAGE(PG8_SA(1, 1), a1 + hstep, voffA);
            PG8_WAIT_V(8); PG8_WAIT_L(0); PG8_BAR; PG8_MMA(0, 0, At, B0); PG8_MMA(0, 1, At, B1); PG8_BAR; PG8_SCHED;
            PG8_LDA(At, 0, 1); PG8_STAGE(PG8_SB(0, 0), b2, voffB); PG8_STAGE(PG8_SB(0, 1), b2 + hstep, voffB); PG8_STAGE(PG8_SA(0, 0), a2, voffA);
            PG8_WAIT_V(8); PG8_WAIT_L(0); PG8_BAR; PG8_MMA(1, 0, At, B0); PG8_MMA(1, 1, At, B1); PG8_BAR; PG8_SCHED;
            PG8_LDB(B0, 1, 0); PG8_LDB(B1, 1, 1); PG8_SCHED; PG8_LDA(At, 1, 0); PG8_STAGE(PG8_SA(0, 1), a2 + hstep, voffA);
            PG8_WAIT_V(8); PG8_WAIT_L(0); PG8_BAR; PG8_MMA(0, 0, At, B0); PG8_MMA(0, 1, At, B1); PG8_BAR; PG8_SCHED;
            PG8_LDA(At, 1, 1); PG8_STAGE(PG8_SB(1, 0), b3, voffB); PG8_STAGE(PG8_SB(1, 1), b3 + hstep, voffB); PG8_STAGE(PG8_SA(1, 0), a3, voffA);
            PG8_WAIT_V(8); PG8_WAIT_L(0); PG8_BAR; PG8_MMA(1, 0, At, B0); PG8_MMA(1, 1, At, B1); PG8_BAR; PG8_SCHED;
            } else {
            PG8_LDB(B0, 0, 0); PG8_SCHED; PG8_LDA(At, 0, 0); PG8_STAGE(PG8_SA(1, 1), a1 + hstep, voffA);
            PG8_WAIT_L(8); PG8_BAR; PG8_WAIT_L(0); PG8_MMA(0, 0, At, B0); PG8_BAR; PG8_SCHED;
            PG8_LDB(B1, 0, 1); PG8_STAGE(PG8_SB(0, 0), b2, voffB);
            PG8_BAR; PG8_WAIT_L(0); PG8_MMA(0, 1, At, B1); PG8_BAR;
            PG8_LDA(At, 0, 1); PG8_STAGE(PG8_SA(0, 0), a2, voffA);
            PG8_BAR; PG8_WAIT_L(0); PG8_MMA(1, 0, At, B0); PG8_BAR; PG8_SCHED;
            PG8_STAGE(PG8_SB(0, 1), b2 + hstep, voffB);
            PG8_WAIT_V(6); PG8_BAR; PG8_MMA(1, 1, At, B1); PG8_BAR;
            PG8_LDB(B0, 1, 0); PG8_SCHED; PG8_LDA(At, 1, 0); PG8_STAGE(PG8_SA(0, 1), a2 + hstep, voffA);
            PG8_WAIT_L(8); PG8_BAR; PG8_WAIT_L(0); PG8_MMA(0, 0, At, B0); PG8_BAR; PG8_SCHED;
            PG8_LDB(B1, 1, 1); PG8_STAGE(PG8_SB(1, 0), b3, voffB);
            PG8_BAR; PG8_WAIT_L(0); PG8_MMA(0, 1, At, B1); PG8_BAR;
            PG8_LDA(At, 1, 1); PG8_STAGE(PG8_SA(1, 0), a3, voffA);
            PG8_BAR; PG8_WAIT_L(0); PG8_MMA(1, 0, At, B0); PG8_BAR; PG8_SCHED;
            PG8_STAGE(PG8_SB(1, 1), b3 + hstep, voffB);
            PG8_WAIT_V(6); PG8_BAR; PG8_MMA(1, 1, At, B1); PG8_BAR;
            }
        }
        if constexpr (ALIGN_EPI) { if (wr == 0) PG8_BAR; }
        if constexpr (!Epi::AFTER_DRAIN) { E(acc, cur, wr, wc, fr, fq); S.done(cur); }
        if (!has_next) break;
#pragma unroll
        for (int a = 0; a < 2; ++a)
#pragma unroll
            for (int b = 0; b < 2; ++b)
#pragma unroll
                for (int m = 0; m < 4; ++m)
#pragma unroll
                    for (int n = 0; n < 2; ++n) acc[a][b][m][n] = (f32x4){0.f, 0.f, 0.f, 0.f};
        cur = nxt; cA = nA; cB = nB; ++ui;
        if constexpr (ALIGN_EPI) { if (wr == 1) PG8_BAR; }
    }
    PG8_WAIT_V(0);
    if constexpr (!ALIGN_EPI) { if (wr == 0) PG8_BAR; }
    PG8_BAR;
    if constexpr (Epi::AFTER_DRAIN) { E.fused(acc, cur, wr, wc, fr, fq, lds, wid, lane); S.done(cur); }
#undef PG8_SA
#undef PG8_SB
#undef PG8_STAGE
#undef PG8_LDA
#undef PG8_LDB
#undef PG8_MMA
#undef PG8_WAIT_V
#undef PG8_WAIT_L
#undef PG8_BAR
#undef PG8_SCHED
}
}
struct Ctx {
    LAS uchar* lds; int tid, lane, wave, G, blk;
    const float* const* in; float* out; uchar* ws;
};
#define WSP(T, off) ((GAS T*)(C.ws + (off)))
#define INP(i) ((const GAS float*)C.in[i])

DI void transpose_item(const GAS float* W, int K, int N, GAS bf16* WT, int vrow0, int scol0, int k0, LAS float* scr, int lane) {
    float wv[32];
#pragma unroll
    for (int i = 0; i < 32; ++i) wv[i] = __builtin_nontemporal_load(W + (size_t)(k0 + 2 * i + (lane >> 5)) * N + scol0 + (lane & 31));
#pragma unroll
    for (int i = 0; i < 32; ++i) scr[(2 * i + (lane >> 5)) * 33 + (lane & 31)] = wv[i];
    asm volatile("s_waitcnt lgkmcnt(0)" ::: "memory");
    const int c = lane & 7;
#pragma unroll
    for (int j = 0; j < 4; ++j) { const int n = (lane >> 3) + 8 * j; const LAS float* s = scr + (8 * c) * 33 + n;
        u32x4 o; o.x = pk2(s[0 * 33], s[1 * 33]); o.y = pk2(s[2 * 33], s[3 * 33]); o.z = pk2(s[4 * 33], s[5 * 33]); o.w = pk2(s[6 * 33], s[7 * 33]);
        *(GAS u32x4*)(WT + (size_t)(vrow0 + n) * K + k0 + 8 * c) = o; }
    asm volatile("s_waitcnt lgkmcnt(0)" ::: "memory");
}
DI int glu_map128(int v, int half_off) { return ((v & 255) >= 128 ? half_off : 0) + 128 * (v >> 8) + (v & 127); }

DI void phase_prep(const Ctx& C) {
    LAS float* scr = (LAS float*)(C.lds + C.wave * 16384);
    const int gw = C.blk * 8 + C.wave, NGW = C.G * 8, lane = C.lane;
    constexpr int N_MODP = 2 * 16 * 36;
    constexpr int T_W1 = 4 * 16 * 176, T_W2 = 4 * 44 * 32, T_EVG = 16 * 32, T_EVO = 16 * 32, T_ODI = 16 * 72, T_ODO = 16 * 32;
    constexpr int N_TR = T_W1 + T_W2 + T_EVG + T_EVO + T_ODI + T_ODO;
    constexpr int N_PQ = 1024 * 4, N_COS = 128, N_DFTC = 1024, N_ROPE = 32;
    constexpr int TOTAL = N_MODP + N_TR + N_PQ + N_COS + N_DFTC + N_ROPE;
    for (int it0 = gw; it0 < TOTAL; it0 += NGW) {
        int it = it0;
        if (it < N_MODP) {
            const int l = it / 576, rem = it % 576, kc = rem / 36, nc = rem % 36, n0 = nc * 256 + 4 * lane;
            const GAS float* wm = INP(I_WMOD) + ((size_t)l * 1024 + kc * 64) * 9216 + n0;
            f32x4 acc[5];
#pragma unroll
            for (int i = 0; i < 5; ++i) acc[i] = (f32x4){0.f, 0.f, 0.f, 0.f};
#pragma unroll 1
            for (int k0 = 0; k0 < 64; k0 += 8) {
                f32x4 w[8];
#pragma unroll
                for (int k = 0; k < 8; ++k) w[k] = __builtin_nontemporal_load((const GAS f32x4*)(wm + (size_t)(k0 + k) * 9216));
#pragma unroll
                for (int k = 0; k < 8; ++k) { const int kk = kc * 64 + k0 + k;
#pragma unroll
                    for (int mi = 0; mi < 5; ++mi) { const float cv = mi < 4 ? INP(I_C)[mi * 1024 + kk] : INP(I_CCTX)[kk]; acc[mi] += silu(cv) * w[k]; } }
            }
            GAS float* mp = WSP(float, WS_MODP);
#pragma unroll
            for (int mi = 0; mi < 5; ++mi) *(GAS f32x4*)(mp + ((size_t)(kc * 2 + l) * 5 + mi) * 9216 + n0) = acc[mi];
            continue;
        }
        it -= N_MODP;
        if (it < N_TR) {
            if (it < T_W1) { const int mat = it / (16 * 176), r = it % (16 * 176), kb = r / 176, nb = r % 176;
                transpose_item(INP(I_FWIN) + (size_t)mat * 1024 * 5632, 1024, 5632, WSP(bf16, WS_W1T) + (size_t)mat * W1T_SZ, 32 * nb, glu_map128(32 * nb, DFF), 64 * kb, scr, lane); continue; }
            it -= T_W1;
            if (it < T_W2) { const int mat = it / (44 * 32), r = it % (44 * 32), kb = r / 32, nb = r % 32;
                transpose_item(INP(I_FWOUT) + (size_t)mat * DFF * 1024, DFF, 1024, WSP(bf16, WS_W2T) + (size_t)mat * W2T_SZ, 32 * nb, 32 * nb, 64 * kb, scr, lane); continue; }
            it -= T_W2;
            if (it < T_EVG) { const int kb = it / 32, nb = it % 32;
                transpose_item(INP(I_EVWIN), 1024, 1536, WSP(bf16, WS_WEVIN), 1024 + 32 * nb, 512 + glu_map128(32 * nb, 512), 64 * kb, scr, lane); continue; }
            it -= T_EVG;
            if (it < T_EVO) { const int kb = it / 32, nb = it % 32; transpose_item(INP(I_EVWOUT), 1024, 1024, WSP(bf16, WS_WEVOUT), 32 * nb, 32 * nb, 64 * kb, scr, lane); continue; }
            it -= T_EVO;
            if (it < T_ODI) { const int kb = it / 72, nb = it % 72; transpose_item(INP(I_ODWIN), 1024, 2304, WSP(bf16, WS_WODIN), 32 * nb, 32 * nb, 64 * kb, scr, lane); continue; }
            it -= T_ODI;
            { const int kb = it / 32, nb = it % 32; transpose_item(INP(I_ODWOUT), 1024, 1024, WSP(bf16, WS_WODOUT), 32 * nb, 32 * nb, 64 * kb, scr, lane); continue; }
        }
        it -= N_TR;
        if (it < N_PQ) {
            const int k = it >> 2, g = it & 3;
            const GAS float* wa = INP(I_EVWIN) + (size_t)k * 1536 + g * 128;
            const float a0 = wa[lane], a1 = wa[64 + lane];
            float p0 = 0.f, q0 = 0.f, p1 = 0.f, q1 = 0.f;
            for (int w = 0; w < 128; ++w) {
                const float aw = __shfl(w < 64 ? a0 : a1, w & 63);
                const int mm = (w * lane) & 127; const float rev = (float)mm * (1.0f / 128.0f); const float s = __builtin_amdgcn_sinf(rev), c = __builtin_amdgcn_cosf(rev);
                const float sg = (w & 1) ? -aw : aw;
                p0 += aw * c; q0 += aw * s; p1 += sg * c; q1 += sg * s;
            }
            GAS bf16* wt = WSP(bf16, WS_WEVIN);
            wt[(size_t)(g * 128 + lane) * 1024 + k] = (bf16)(pk2(p0, 0.f) & 0xffff);
            wt[(size_t)(g * 128 + 64 + lane) * 1024 + k] = (bf16)(pk2(p1, 0.f) & 0xffff);
            wt[(size_t)(512 + g * 128 + lane) * 1024 + k] = (bf16)(pk2(q0, 0.f) & 0xffff);
            wt[(size_t)(512 + g * 128 + 64 + lane) * 1024 + k] = (bf16)(pk2(q1, 0.f) & 0xffff);
            continue;
        }
        it -= N_PQ;
        if (it < N_COS) { const int mm = it * 64 + lane; float s, c; sincospif((float)mm * (1.0f / 4096.0f), &s, &c);
            WSP(bf16, WS_COST)[mm] = (bf16)(pk2(c, 0.f) & 0xffff); WSP(bf16, WS_NSIN)[mm] = (bf16)(pk2(-s, 0.f) & 0xffff); continue; }
        it -= N_COS;
        if (it < N_DFTC) { const int idx = it * 64 + lane, j = idx >> 8, kk = idx & 255; float v;
            if (kk <= 128) v = cospif((float)((j * kk) & 255) * (1.0f / 128.0f)); else v = -sinpif((float)((j * (kk - 128)) & 255) * (1.0f / 128.0f));
            WSP(bf16, WS_DFTC)[idx] = (bf16)(pk2(v, 0.f) & 0xffff); continue; }
        it -= N_DFTC;
        { const int idx = it * 64 + lane, p = idx >> 4, i = idx & 15; const float inv = powf(10000.0f, -(float)i * (1.0f / 16.0f)); const float ang = (float)p * inv;
            f32x2_t cs; cs.x = cosf(ang); cs.y = sinf(ang); WSP(f32x2_t, WS_ROPE)[idx] = cs; }
    }
}

DI void phase_modred(const Ctx& C) {
    const GAS float* mp = WSP(float, WS_MODP); GAS float* mo = WSP(float, WS_MOD);
    for (int idx = C.blk * 512 + C.tid; idx < 2 * 5 * 9216; idx += C.G * 512) {
        const int l = idx / 46080, rem = idx % 46080, mi = rem / 9216, n = rem % 9216;
        float s = INP(I_BMOD)[l * 9216 + n];
#pragma unroll
        for (int kc = 0; kc < 16; ++kc) s += mp[((size_t)(kc * 2 + l) * 5 + mi) * 9216 + n];
        mo[idx] = s;
    }
}

DI void phase_e(const Ctx& C, int nslab, int has_post, int pl, int ps, float pw, int has_pre, int ql, int qs, int nrows,
                const GAS float* xsrc, const GAS float* csrc, GAS float* xdst, GAS float* cdst, bool xs16, bool xd16) {
    const int lane = C.lane;
#define ECOL(j) (512 * ((j) >> 1) + 8 * lane + 4 * ((j) & 1))
    const int xpb = (MX + C.G - 1) / C.G, cpb = nrows > MX ? (MC + C.G - 1) / C.G : 0, total = xpb + cpb;
    const GAS float* mod = WSP(float, WS_MOD); const GAS bf16* Y = WSP(bf16, WS_Y); const GAS bf16* YS = WSP(bf16, WS_YS); GAS bf16* H = WSP(bf16, WS_H);
    f32x4 gpo[4], gpr[4], gt[4], sc[4], sh[4]; int cur = -1;
#pragma unroll
    for (int j = 0; j < 4; ++j) {
        gpo[j] = has_post ? *(const GAS f32x4*)(INP(I_NPOST) + (pl * 3 + ps) * 1024 + ECOL(j)) : (f32x4){0.f, 0.f, 0.f, 0.f};
        gpr[j] = has_pre ? *(const GAS f32x4*)(INP(I_NPRE) + (ql * 3 + qs) * 1024 + ECOL(j)) : (f32x4){0.f, 0.f, 0.f, 0.f};
        gt[j] = sc[j] = sh[j] = (f32x4){0.f, 0.f, 0.f, 0.f};
    }
    f32x4 vN[4], vM[4]; u32x2 yN[4], yM[4];
#define E_ROW(i) ((i) < xpb ? C.blk * xpb + (i) : MX + C.blk * cpb + ((i) - xpb))
#define E_LOAD(i, V, Yw) do { const int row_ = E_ROW(i); const bool isx_ = row_ < MX; \
        if (isx_ && xs16) { const GAS bf16* s16_ = (const GAS bf16*)xsrc + (size_t)row_ * 1024; \
            _Pragma("unroll") for (int q = 0; q < 2; ++q) { const u32x4 w_ = __builtin_nontemporal_load((const GAS u32x4*)(s16_ + ECOL(2 * q))); V[2 * q] = (f32x4){bflo(w_.x), bfhi(w_.x), bflo(w_.y), bfhi(w_.y)}; V[2 * q + 1] = (f32x4){bflo(w_.z), bfhi(w_.z), bflo(w_.w), bfhi(w_.w)}; } } \
        else { const GAS float* src_ = isx_ ? xsrc + (size_t)row_ * 1024 : csrc + (size_t)(row_ - MX) * 1024; \
            _Pragma("unroll") for (int j = 0; j < 4; ++j) V[j] = __builtin_nontemporal_load((const GAS f32x4*)(src_ + ECOL(j))); } \
        if (has_post && (isx_ || nslab == 0)) { _Pragma("unroll") for (int q = 0; q < 2; ++q) { const u32x4 w_ = __builtin_nontemporal_load((const GAS u32x4*)(Y + (size_t)row_ * 1024 + ECOL(2 * q))); Yw[2 * q] = (u32x2){w_.x, w_.y}; Yw[2 * q + 1] = (u32x2){w_.z, w_.w}; } } } while (0)
    int i = C.wave;
    if (i < total) E_LOAD(i, vN, yN);
    if (i + 8 < total) E_LOAD(i + 8, vM, yM);
    for (; i < total; i += 8) {
        const int row = E_ROW(i);
        const bool isx = row < MX; const int mi = isx ? (row >> 13) : 4;
        f32x4 v[4]; u32x2 yw[4];
#pragma unroll
        for (int j = 0; j < 4; ++j) { v[j] = vN[j]; yw[j] = yN[j]; vN[j] = vM[j]; yN[j] = yM[j]; }
        if (i + 16 < total) E_LOAD(i + 16, vM, yM);
        if (mi != cur) { cur = mi;
#pragma unroll
            for (int j = 0; j < 4; ++j) {
                if (has_post) gt[j] = *(const GAS f32x4*)(mod + (size_t)(pl * 5 + mi) * 9216 + (3 * ps + 2) * 1024 + ECOL(j));
                if (has_pre) { sc[j] = *(const GAS f32x4*)(mod + (size_t)(ql * 5 + mi) * 9216 + (3 * qs + 1) * 1024 + ECOL(j));
                               sh[j] = *(const GAS f32x4*)(mod + (size_t)(ql * 5 + mi) * 9216 + (3 * qs) * 1024 + ECOL(j)); }
            } }
        if (has_post) {
            f32x4 y[4]; float ss = 0.f;
#pragma unroll
            for (int j = 0; j < 4; ++j) {
                if (isx || nslab == 0) { y[j] = (f32x4){bflo(yw[j].x), bfhi(yw[j].x), bflo(yw[j].y), bfhi(yw[j].y)}; }
                else { y[j] = (f32x4){0.f, 0.f, 0.f, 0.f};
                    for (int s = 0; s < nslab; ++s) { const u32x2 w = *(const GAS u32x2*)(YS + ((size_t)s * MC + (row - MX)) * 1024 + ECOL(j)); y[j] += (f32x4){bflo(w.x), bfhi(w.x), bflo(w.y), bfhi(w.y)}; } }
                ss += (y[j][0] * y[j][0] + y[j][1] * y[j][1]) + (y[j][2] * y[j][2] + y[j][3] * y[j][3]); }
            const float r = rsqrtf(wave_sum(ss) * (1.0f / 1024.0f) + EPS);
            if (isx && xd16) { GAS bf16* d16 = (GAS bf16*)xdst + (size_t)row * 1024;
#pragma unroll
                for (int q = 0; q < 2; ++q) { u32x4 w;
                    { const int j = 2 * q; v[j] += pw * gt[j] * ((y[j] * r) * gpo[j]); w.x = pk2(v[j][0], v[j][1]); w.y = pk2(v[j][2], v[j][3]); v[j] = (f32x4){bflo(w.x), bfhi(w.x), bflo(w.y), bfhi(w.y)}; }
                    { const int j = 2 * q + 1; v[j] += pw * gt[j] * ((y[j] * r) * gpo[j]); w.z = pk2(v[j][0], v[j][1]); w.w = pk2(v[j][2], v[j][3]); v[j] = (f32x4){bflo(w.z), bfhi(w.z), bflo(w.w), bfhi(w.w)}; }
                    __builtin_nontemporal_store(w, (GAS u32x4*)(d16 + ECOL(2 * q))); }
            } else { GAS float* dst = isx ? xdst + (size_t)row * 1024 : cdst + (size_t)(row - MX) * 1024;
#pragma unroll
                for (int j = 0; j < 4; ++j) { v[j] += pw * gt[j] * ((y[j] * r) * gpo[j]); __builtin_nontemporal_store(v[j], (GAS f32x4*)(dst + ECOL(j))); } }
        }
        if (has_pre) {
            float ss = 0.f;
#pragma unroll
            for (int j = 0; j < 4; ++j) ss += (v[j][0] * v[j][0] + v[j][1] * v[j][1]) + (v[j][2] * v[j][2] + v[j][3] * v[j][3]);
            const float r = rsqrtf(wave_sum(ss) * (1.0f / 1024.0f) + EPS);
#pragma unroll
            for (int q = 0; q < 2; ++q) { const f32x4 h0 = ((v[2 * q] * r) * gpr[2 * q]) * (1.0f + sc[2 * q]) + sh[2 * q], h1 = ((v[2 * q + 1] * r) * gpr[2 * q + 1]) * (1.0f + sc[2 * q + 1]) + sh[2 * q + 1];
                u32x4 w; w.x = pk2(h0[0], h0[1]); w.y = pk2(h0[2], h0[3]); w.z = pk2(h1[0], h1[1]); w.w = pk2(h1[2], h1[3]); *(GAS u32x4*)(H + (size_t)row * 1024 + ECOL(2 * q)) = w; }
        }
    }
#undef E_ROW
#undef E_LOAD
#undef ECOL
}

DI void phase_dftm(const Ctx& C) {
    GAS bf16* D = WSP(bf16, WS_DFTM);
    for (int ch = C.blk * 512 + C.tid; ch < 4096 * 1024; ch += C.G * 512) {
        const int j = ch >> 10, kc = ch & 1023;
        float e[8];
#pragma unroll
        for (int i = 0; i < 8; ++i) { const int kk = 8 * kc + i;
            const float rev = (float)((j * (kk & 4095)) & 8191) * (1.0f / 8192.0f);
            e[i] = (kk < 4096) ? __builtin_amdgcn_cosf(rev) : __builtin_amdgcn_sinf(rev); }
        u32x4 w; w.x = pk2(e[0], e[1]); w.y = pk2(e[2], e[3]); w.z = pk2(e[4], e[5]); w.w = pk2(e[6], e[7]);
        *(GAS u32x4*)(D + (size_t)ch * 8) = w;
    }
}
DI void phase_unfold(const Ctx& C) {
    const GAS bf16* DS = WSP(bf16, WS_DS); const GAS bf16* PQ = WSP(bf16, WS_PQ); GAS bf16* MIX = WSP(bf16, WS_H);
    constexpr size_t SL = (size_t)4096 * 2048; constexpr float SC = 1.0f / 1024.0f;
    for (int it = C.blk * 512 + C.tid; it < 4096 * 256; it += C.G * 512) {
        const int j = it >> 8, n = (it & 255) * 8, b = n >> 9, ch = n & 511;
        const u32x4 c = *(const GAS u32x4*)(DS + (size_t)j * 2048 + n), s = *(const GAS u32x4*)(DS + SL + (size_t)j * 2048 + n);
        const u32x4 e = *(const GAS u32x4*)(PQ + ((size_t)b * SEQ + 4096) * 1024 + ch);
        const float sg = (j & 1) ? -1.0f : 1.0f;
        const unsigned cw[4] = {c.x, c.y, c.z, c.w}, sw[4] = {s.x, s.y, s.z, s.w}, ew[4] = {e.x, e.y, e.z, e.w};
        unsigned o1[4], o2[4];
#pragma unroll
        for (int q = 0; q < 4; ++q) { const float c0 = bflo(cw[q]) + sg * bflo(ew[q]), c1 = bfhi(cw[q]) + sg * bfhi(ew[q]), s0 = bflo(sw[q]), s1 = bfhi(sw[q]);
            o1[q] = pk2((c0 - s0) * SC, (c1 - s1) * SC); o2[q] = pk2((c0 + s0) * SC, (c1 + s1) * SC); }
        *(GAS u32x4*)(MIX + ((size_t)b * SEQ + j) * 1024 + ch) = (u32x4){o1[0], o1[1], o1[2], o1[3]};
        if (j > 0) *(GAS u32x4*)(MIX + ((size_t)b * SEQ + SEQ - j) * 1024 + ch) = (u32x4){o2[0], o2[1], o2[2], o2[3]};
    }
    LAS float* red = (LAS float*)C.lds;
    for (int nc = C.blk; nc < 256; nc += C.G) {
        const int n = nc * 8, b = n >> 9, ch = n & 511;
        float acc[8];
#pragma unroll
        for (int i = 0; i < 8; ++i) acc[i] = 0.f;
        for (int l = C.tid; l < SEQ; l += 512) { const u32x4 p = *(const GAS u32x4*)(PQ + ((size_t)b * SEQ + l) * 1024 + ch);
            acc[0] += bflo(p.x); acc[1] += bfhi(p.x); acc[2] += bflo(p.y); acc[3] += bfhi(p.y); acc[4] += bflo(p.z); acc[5] += bfhi(p.z); acc[6] += bflo(p.w); acc[7] += bfhi(p.w); }
        const float sg = (C.tid & 1) ? -1.0f : 1.0f;
#pragma unroll
        for (int i = 0; i < 8; ++i) { const float t = wave_sum(acc[i] * sg); if (C.lane == 0) red[C.wave * 8 + i] = t; }
        __syncthreads();
        if (C.tid < 8) { float t = 0.f;
#pragma unroll
            for (int wv = 0; wv < 8; ++wv) t += red[wv * 8 + C.tid];
            MIX[((size_t)b * SEQ + 4096) * 1024 + ch + C.tid] = (bf16)(pk2(t * SC, 0.f) & 0xffff); }
        __syncthreads();
    }
}

DI void fold_tiles(const Ctx& C, const GAS bf16* PQ, int rowbase, int L, GAS bf16* Bt, bool jf) {
    LAS bf16* sm = (LAS bf16*)C.lds;
    const int nkb = L / 64, ntiles = 8 * nkb, half = L / 2;
    const int rl = C.tid >> 3, c8 = C.tid & 7;
    for (int tile = C.blk; tile < ntiles; tile += C.G) {
        const int nb = tile / nkb, kb = tile % nkb, n0 = nb * 256, b = n0 >> 9, ch0 = n0 & 511, kk = kb * 64 + rl;
        int colb, l1, l2; bool has2; float sg, sa = 1.f;
        if (jf) {
            if (kk < half) { colb = ch0; l1 = kk; l2 = L - kk; has2 = (kk != 0); sg = 1.f; }
            else { colb = 512 + ch0; l1 = kk - half; l2 = L - l1; has2 = (kk != half); sg = -1.f; if (kk == half) sa = 0.f; }
        } else {
            if (kk <= half) { colb = ch0; l1 = kk; l2 = L - kk; has2 = (kk != 0 && kk != half); sg = 1.f; }
            else { colb = 512 + ch0; l1 = kk - half; l2 = L - l1; has2 = true; sg = -1.f; }
        }
        if (!has2) { l2 = l1; sg = 0.f; }
        u32x4 a[4], bb[4];
#pragma unroll
        for (int q = 0; q < 4; ++q) { a[q] = *(const GAS u32x4*)(PQ + (size_t)(rowbase + b * L + l1) * 1024 + colb + 64 * q + 8 * c8);
                                      bb[q] = *(const GAS u32x4*)(PQ + (size_t)(rowbase + b * L + l2) * 1024 + colb + 64 * q + 8 * c8); }
#pragma unroll
        for (int q = 0; q < 4; ++q) {
            float f[8];
            f[0] = sa * bflo(a[q].x) + sg * bflo(bb[q].x); f[1] = sa * bfhi(a[q].x) + sg * bfhi(bb[q].x); f[2] = sa * bflo(a[q].y) + sg * bflo(bb[q].y); f[3] = sa * bfhi(a[q].y) + sg * bfhi(bb[q].y);
            f[4] = sa * bflo(a[q].z) + sg * bflo(bb[q].z); f[5] = sa * bfhi(a[q].z) + sg * bfhi(bb[q].z); f[6] = sa * bflo(a[q].w) + sg * bflo(bb[q].w); f[7] = sa * bfhi(a[q].w) + sg * bfhi(bb[q].w);
#pragma unroll
            for (int i = 0; i < 8; ++i) sm[(64 * q + 8 * c8 + i) * 72 + rl] = (bf16)(pk2(f[i], 0.f) & 0xffff);
        }
        __syncthreads();
#pragma unroll
        for (int q = 0; q < 4; ++q) { const u32x4 o = *(const LAS u32x4*)(sm + (64 * q + rl) * 72 + 8 * c8);
            *(GAS u32x4*)(Bt + (size_t)(n0 + 64 * q + rl) * L + kb * 64 + 8 * c8) = o; }
        __syncthreads();
    }
}
DI void phase_conv(const Ctx& C) {
    LAS float* cw = (LAS float*)(C.lds + 16384);
    for (int i = C.tid; i < 31 * 512; i += 512) cw[i] = INP(I_EVCW)[i];
    __syncthreads();
    const GAS bf16* UG = WSP(bf16, WS_UG); GAS bf16* MIX = WSP(bf16, WS_H);
    const int lane = C.lane, c0 = 8 * lane;
    f32x4 bias0 = *(const GAS f32x4*)(INP(I_EVCB) + c0), bias1 = *(const GAS f32x4*)(INP(I_EVCB) + c0 + 4);
    f32x4 lg0 = *(const GAS f32x4*)(INP(I_EVLNG) + c0), lg1 = *(const GAS f32x4*)(INP(I_EVLNG) + c0 + 4);
    f32x4 lb0 = *(const GAS f32x4*)(INP(I_EVLNB) + c0), lb1 = *(const GAS f32x4*)(INP(I_EVLNB) + c0 + 4);
    const int rpb = (MT + C.G - 1) / C.G, row0 = C.blk * rpb, row1 = (row0 + rpb < MT) ? row0 + rpb : MT;
    for (int row = row0 + C.wave; row < row1; row += 8) {
        int sb, l, L;
        if (row < MX) { sb = row & ~8191; l = row & 8191; L = SEQ; } else { sb = MX + ((row - MX) & ~255); l = (row - MX) & 255; L = CTX; }
        f32x4 a0 = bias0, a1 = bias1;
#pragma unroll 8
        for (int tap = 0; tap < 31; ++tap) {
            const int lp = l + tap - 15; const bool ok = lp >= 0 && lp < L; const int lc = ok ? lp : l;
            const u32x4 u = *(const GAS u32x4*)(UG + (size_t)(sb + lc) * 512 + c0);
            const float z = ok ? 1.0f : 0.0f;
            const f32x4 w0 = *(const LAS f32x4*)(cw + tap * 512 + c0) * z, w1 = *(const LAS f32x4*)(cw + tap * 512 + c0 + 4) * z;
            a0 += w0 * (f32x4){bflo(u.x), bfhi(u.x), bflo(u.y), bfhi(u.y)};
            a1 += w1 * (f32x4){bflo(u.z), bfhi(u.z), bflo(u.w), bfhi(u.w)};
        }
        const float mean = wave_sum((a0[0] + a0[1]) + (a0[2] + a0[3]) + (a1[0] + a1[1]) + (a1[2] + a1[3])) * (1.0f / 512.0f);
        a0 -= mean; a1 -= mean;
        const float var = wave_sum((a0[0] * a0[0] + a0[1] * a0[1]) + (a0[2] * a0[2] + a0[3] * a0[3]) + (a1[0] * a1[0] + a1[1] * a1[1]) + (a1[2] * a1[2] + a1[3] * a1[3])) * (1.0f / 512.0f);
        const float r = rsqrtf(var + EPS);
        a0 = a0 * r * lg0 + lb0; a1 = a1 * r * lg1 + lb1;
        u32x4 o; o.x = pk2(silu(a0[0]), silu(a0[1])); o.y = pk2(silu(a0[2]), silu(a0[3])); o.z = pk2(silu(a1[0]), silu(a1[1])); o.w = pk2(silu(a1[2]), silu(a1[3]));
        *(GAS u32x4*)(MIX + (size_t)row * 1024 + 512 + c0) = o;
    }
    __syncthreads();
}

DI int crow(int reg, int h) { return (reg & 3) + 8 * (reg >> 2) + 4 * h; }
DI void glds16(const GAS uchar* g, LAS uchar* l) { __builtin_amdgcn_global_load_lds((const GAS unsigned*)g, (LAS unsigned*)l, 16, 0, 0); }
template <int DVB, bool MASK, bool KW16>
DI void attn_tile(const LAS uchar* Kb, int kc0, const LAS uchar* Vb, const bf16x8 (&qf)[4], f32x16 (&O)[DVB], float& m, f32x16& negm, float& l, int r, int hh, int tq, int tk0, bool force) {
    constexpr int RB = KW16 ? 256 : 128;
    const int ksw = KW16 ? (r & 15) : ((r >> 1) & 7), vsw = (r >> 1) & 7;
    const LAS uchar* kp = Kb + r * RB;
    const LAS uchar* vp = Vb + r * 128;
    bf16x8 kf[2][4];
#pragma unroll
    for (int kb = 0; kb < 2; ++kb)
#pragma unroll
        for (int s = 0; s < 4; ++s) kf[kb][s] = *(const LAS bf16x8*)(kp + kb * 32 * RB + (((kc0 + 2 * s + hh) ^ ksw) * 16));
    f32x16 S[2];
    __builtin_amdgcn_s_setprio(1);
#pragma unroll
    for (int kb = 0; kb < 2; ++kb) S[kb] = MFMA32(kf[kb][0], qf[0], negm);
#pragma unroll
    for (int s = 1; s < 4; ++s)
#pragma unroll
        for (int kb = 0; kb < 2; ++kb) S[kb] = MFMA32(kf[kb][s], qf[s], S[kb]);
    __builtin_amdgcn_s_setprio(0);
    bf16x8 vf[2][DVB];
#pragma unroll
    for (int d = 0; d < DVB; ++d) vf[0][d] = *(const LAS bf16x8*)(vp + d * 32 * 128 + ((hh ^ vsw) * 16));
    float mx = -3.0e38f;
#pragma unroll
    for (int kb = 0; kb < 2; ++kb)
#pragma unroll
        for (int i = 0; i < 16; ++i) { float t = S[kb][i];
            if (MASK) { const int dk = tk0 + 32 * kb + crow(i, hh) - tq; t = (dk <= 128 && dk >= -128) ? t : -1e30f; S[kb][i] = t; }
            mx = fmaxf(mx, t); }
    if (force || __builtin_amdgcn_ballot_w64(mx > 8.0f) != 0ull) {
        mx = fmaxf(mx, __shfl_xor(mx, 32));
        const float delta = force ? mx : fmaxf(mx, 0.f);
        const float alpha = __builtin_amdgcn_exp2f(-delta);
        m += delta; l *= alpha;
#pragma unroll
        for (int i = 0; i < 16; ++i) negm[i] = -m;
#pragma unroll
        for (int d = 0; d < DVB; ++d) O[d] *= alpha;
#pragma unroll
        for (int kb = 0; kb < 2; ++kb)
#pragma unroll
            for (int i = 0; i < 16; ++i) S[kb][i] -= delta;
    }
    const bf16x2_t ones = __builtin_bit_cast(bf16x2_t, 0x3f803f80u);
#pragma unroll
    for (int step = 0; step < 4; ++step) {
        const int kb = step >> 1, s2 = step & 1;
        if (step < 3) {
#pragma unroll
            for (int d = 0; d < DVB; ++d) vf[(step + 1) & 1][d] = *(const LAS bf16x8*)(vp + d * 32 * 128 + (((2 * (step + 1) + hh) ^ vsw) * 16));
        }
        u32x4 pw;
        pw.x = pk2(__builtin_amdgcn_exp2f(S[kb][8 * s2 + 0]), __builtin_amdgcn_exp2f(S[kb][8 * s2 + 1])); pw.y = pk2(__builtin_amdgcn_exp2f(S[kb][8 * s2 + 2]), __builtin_amdgcn_exp2f(S[kb][8 * s2 + 3]));
        pw.z = pk2(__builtin_amdgcn_exp2f(S[kb][8 * s2 + 4]), __builtin_amdgcn_exp2f(S[kb][8 * s2 + 5])); pw.w = pk2(__builtin_amdgcn_exp2f(S[kb][8 * s2 + 6]), __builtin_amdgcn_exp2f(S[kb][8 * s2 + 7]));
        l += (bflo(pw.x) + bfhi(pw.x)) + (bflo(pw.y) + bfhi(pw.y)) + (bflo(pw.z) + bfhi(pw.z)) + (bflo(pw.w) + bfhi(pw.w));
        const bf16x8 pf = __builtin_bit_cast(bf16x8, pw);
#pragma unroll
        for (int d = 0; d < DVB; ++d) O[d] = MFMA32(vf[step & 1][d], pf, O[d]);
    }
    __builtin_amdgcn_sched_group_barrier(0x002, 20, 0);
#pragma unroll
    for (int st = 0; st < 3; ++st) {
        __builtin_amdgcn_sched_group_barrier(0x100, DVB, 0);
#pragma unroll
        for (int d = 0; d < DVB; ++d) { __builtin_amdgcn_sched_group_barrier(0x008, 1, 0); __builtin_amdgcn_sched_group_barrier(0x002, (20 + DVB - 1) / DVB, 0); }
    }
    __builtin_amdgcn_sched_group_barrier(0x008, DVB, 0);
}

DI void qk_scores(const LAS uchar* Kb, int kc0, const bf16x8 (&qf)[4], f32x16 (&S)[2], int r, int hh) {
    const int ksw = r & 15; const LAS uchar* kp = Kb + r * 256;
#pragma unroll
    for (int kb = 0; kb < 2; ++kb) {
        bf16x8 kf[4];
#pragma unroll
        for (int s = 0; s < 4; ++s) kf[s] = *(const LAS bf16x8*)(kp + kb * 32 * 256 + (((kc0 + 2 * s + hh) ^ ksw) * 16));
        { const f32x16 zero16 = {0.f, 0.f, 0.f, 0.f, 0.f, 0.f, 0.f, 0.f, 0.f, 0.f, 0.f, 0.f, 0.f, 0.f, 0.f, 0.f}; S[kb] = MFMA32(kf[0], qf[0], zero16); }
#pragma unroll
        for (int s = 1; s < 4; ++s) S[kb] = MFMA32(kf[s], qf[s], S[kb]);
    }
}
template <bool HASNEXT>
DI void attn_tile_pipe(const LAS uchar* Kn, int kc0, const LAS uchar* Vb, const bf16x8 (&qf)[4], f32x16 (&O)[4], f32x16 (&S)[2], f32x16 (&Sn)[2], float& m, float& l, int r, int hh, bool force) {
    constexpr int DVB = 4;
    const int ksw = r & 15, vsw = (r >> 1) & 7;
    const LAS uchar* vp = Vb + r * 128;
    const LAS uchar* kp = Kn + r * 256;
    bf16x8 kf[4];
    if (HASNEXT) {
#pragma unroll
        for (int s = 0; s < 4; ++s) kf[s] = *(const LAS bf16x8*)(kp + (((kc0 + 2 * s + hh) ^ ksw) * 16)); }
    bf16x8 vf[DVB];
#pragma unroll
    for (int d = 0; d < DVB; ++d) vf[d] = *(const LAS bf16x8*)(vp + d * 32 * 128 + ((hh ^ vsw) * 16));
    float mx0 = S[0][0], mx1 = S[1][0];
#pragma unroll
    for (int i = 1; i < 16; ++i) { mx0 = fmaxf(mx0, S[0][i]); mx1 = fmaxf(mx1, S[1][i]); }
    float mx = fmaxf(mx0, mx1);
    if (force || __builtin_amdgcn_ballot_w64(mx > m + 8.0f) != 0ull) {
        mx = fmaxf(mx, __shfl_xor(mx, 32));
        const float mn = force ? mx : fmaxf(mx, m);
        const float alpha = __builtin_amdgcn_exp2f(m - mn);
        m = mn; l *= alpha;
#pragma unroll
        for (int d = 0; d < DVB; ++d) O[d] *= alpha;
    }
    const f32x16 zero16 = {0.f, 0.f, 0.f, 0.f, 0.f, 0.f, 0.f, 0.f, 0.f, 0.f, 0.f, 0.f, 0.f, 0.f, 0.f, 0.f};
    float la0 = 0.f;
    u32x4 pw;
#define ATT_P(step) do { const int kb_ = (step) >> 1, s2_ = (step) & 1; \
        { const float e0 = __builtin_amdgcn_exp2f(S[kb_][8 * s2_ + 0] - m), e1 = __builtin_amdgcn_exp2f(S[kb_][8 * s2_ + 1] - m), e2 = __builtin_amdgcn_exp2f(S[kb_][8 * s2_ + 2] - m), e3 = __builtin_amdgcn_exp2f(S[kb_][8 * s2_ + 3] - m); \
          la0 += e0; la0 += e1; la0 += e2; la0 += e3;        \
          pw.x = pk2(e0, e1); pw.y = pk2(e2, e3); } \
        { const float e4 = __builtin_amdgcn_exp2f(S[kb_][8 * s2_ + 4] - m), e5 = __builtin_amdgcn_exp2f(S[kb_][8 * s2_ + 5] - m), e6 = __builtin_amdgcn_exp2f(S[kb_][8 * s2_ + 6] - m), e7 = __builtin_amdgcn_exp2f(S[kb_][8 * s2_ + 7] - m); \
          la0 += e4; la0 += e5; la0 += e6; la0 += e7; \
          pw.z = pk2(e4, e5); pw.w = pk2(e6, e7); } } while (0)
    if (HASNEXT) {
        __builtin_amdgcn_sched_barrier(0);
        Sn[0] = MFMA32(kf[0], qf[0], zero16);
#pragma unroll
        for (int s = 1; s < 4; ++s) Sn[0] = MFMA32(kf[s], qf[s], Sn[0]);
        __builtin_amdgcn_sched_barrier(0);
#pragma unroll
        for (int s = 0; s < 4; ++s) kf[s] = *(const LAS bf16x8*)(kp + 32 * 256 + (((kc0 + 2 * s + hh) ^ ksw) * 16));
        __builtin_amdgcn_sched_barrier(0);
    }
    ATT_P(0);
    if (HASNEXT) {
        __builtin_amdgcn_sched_barrier(0);
        Sn[1] = MFMA32(kf[0], qf[0], zero16);
#pragma unroll
        for (int s = 1; s < 4; ++s) Sn[1] = MFMA32(kf[s], qf[s], Sn[1]);
    }
#pragma unroll
    for (int step = 0; step < 4; ++step) {
        const bf16x8 pf = __builtin_bit_cast(bf16x8, pw);
        __builtin_amdgcn_sched_barrier(0);
#pragma unroll
        for (int d = 0; d < DVB; ++d) O[d] = MFMA32(vf[d], pf, O[d]);
        __builtin_amdgcn_sched_barrier(0);
        if (step < 3) {
#pragma unroll
            for (int d = 0; d < DVB; ++d) vf[d] = *(const LAS bf16x8*)(vp + d * 32 * 128 + (((2 * (step + 1) + hh) ^ vsw) * 16));
            __builtin_amdgcn_sched_barrier(0);
            ATT_P(step + 1);
        }
    }
#undef ATT_P
    l += la0;
}

constexpr int DSUB = 32768, DBUF = 2 * DSUB;
constexpr int WBUF = 16384;
static_assert(2 * DBUF <= LDS_BYTES, "attention LDS");
#define ATT_WAIT_BAR() do { asm volatile("s_waitcnt vmcnt(0)" ::: "memory"); __syncthreads(); } while (0)

DI void phase_attn(const Ctx& C) {
    const int lane = C.lane, w = C.wave, r = lane & 31, hh = lane >> 5;
    const GAS bf16* QD = WSP(bf16, WS_QD); const GAS bf16* QW = WSP(bf16, WS_QW); const GAS uchar* DK = WSP(uchar, WS_DK); const GAS uchar* DVT = WSP(uchar, WS_DVT);
    const GAS uchar* WK = WSP(uchar, WS_WK); const GAS uchar* WVT = WSP(uchar, WS_WVT); GAS bf16* ATT = WSP(bf16, WS_H);
    float lam;
    { const GAS float* lv = INP(I_ODLAM); const float a = wave_sum(lv[lane] * lv[64 + lane]), b = wave_sum(lv[128 + lane] * lv[192 + lane]); lam = __expf(a) - __expf(b) + LAM_INIT; }
    {
    unsigned koffs[4], voffs[4]; int kl[4], vl[4];
#pragma unroll
    for (int i = 0; i < 4; ++i) { const int qi = w * 4 + i, st = qi >> 4, q = qi & 15;
        const int row = 4 * q + (lane >> 4), c = (lane & 15) ^ (row & 15);
        koffs[i] = (unsigned)((st * 64 + row) * 512) * 2u + c * 16; kl[i] = st * DSUB + q * 1024;
        const int rowv = 8 * q + (lane >> 3), cv = (lane & 7) ^ ((rowv >> 1) & 7);
        voffs[i] = (unsigned)(rowv * KV + st * 64) * 2u + cv * 16; vl[i] = st * DSUB + 16384 + q * 1024; }
    const int nrounds_d = (1024 + C.G - 1) / C.G;
    for (int it = 0; it < nrounds_d; ++it) {
        int unit;
        if (C.G == 256) { const int x = C.blk & 7, cix = C.blk >> 3; unit = (x + 8 * (it >> 1)) * 64 + (it & 1) * 32 + cix; } else unit = it * C.G + C.blk;
        if (unit >= 1024) break;
        const int b = unit >> 8, h = (unit >> 6) & 3, qblk = unit & 63, qb4 = w >> 1, sub = w & 1;
        const int qrow = b * SEQ + qblk * 128 + qb4 * 32 + r;
        bf16x8 qf[4];
#pragma unroll
        for (int s = 0; s < 4; ++s) qf[s] = *(const GAS bf16x8*)(QD + (size_t)qrow * 512 + h * 128 + sub * 64 + 16 * s + 8 * hh);
        f32x16 O[4];
#pragma unroll
        for (int d = 0; d < 4; ++d)
#pragma unroll
            for (int i = 0; i < 16; ++i) O[d][i] = 0.f;
        float m = 0.f, l = 0.f; f32x16 negm;
#pragma unroll
        for (int i = 0; i < 16; ++i) negm[i] = 0.f;
        const GAS uchar* kbase = DK + ((size_t)b * KV * 512 + h * 128) * 2;
        const GAS uchar* vbase = DVT + ((size_t)(b * 512 + h * 128) * KV) * 2;
#define ATT_ISSUE(kt, Bn) do { const GAS uchar* kg_ = kbase + (size_t)(kt) * (128 * 512 * 2); const GAS uchar* vg_ = vbase + (kt) * 256; asm volatile("" : "+s"(kg_), "+s"(vg_)); \
            _Pragma("unroll") for (int i = 0; i < 4; ++i) { glds16(kg_ + koffs[i], (Bn) + kl[i]); glds16(vg_ + voffs[i], (Bn) + vl[i]); } } while (0)
        ATT_ISSUE(0, C.lds);
        ATT_WAIT_BAR();
        constexpr int NT = KV / 128;
        f32x16 Sc[2], Sx[2];
        qk_scores(C.lds, sub * 8, qf, Sc, r, hh);
#pragma unroll 1
        for (int kt = 0; kt < NT - 1; ++kt) {
            { LAS uchar* Bn = C.lds + ((kt + 1) & 1) * DBUF; ATT_ISSUE(kt + 1, Bn); }
            const LAS uchar* B = C.lds + (kt & 1) * DBUF;
            attn_tile_pipe<true>(B + DSUB, sub * 8, B + 16384, qf, O, Sc, Sx, m, l, r, hh, kt == 0);
            attn_tile_pipe<false>(B, sub * 8, B + DSUB + 16384, qf, O, Sx, Sc, m, l, r, hh, false);
            ATT_WAIT_BAR();
            qk_scores(C.lds + ((kt + 1) & 1) * DBUF, sub * 8, qf, Sc, r, hh);
        }
        { const LAS uchar* B = C.lds + ((NT - 1) & 1) * DBUF;
            attn_tile_pipe<true>(B + DSUB, sub * 8, B + 16384, qf, O, Sc, Sx, m, l, r, hh, false);
            attn_tile_pipe<false>(B, sub * 8, B + DSUB + 16384, qf, O, Sx, Sc, m, l, r, hh, false);
            ATT_WAIT_BAR(); }
#undef ATT_ISSUE
        const float inv = 1.0f / (l + __shfl_xor(l, 32));
        LAS float* ex = (LAS float*)C.lds + qb4 * 4096;
        if (sub == 1) {
#pragma unroll
            for (int d = 0; d < 4; ++d)
#pragma unroll
                for (int i = 0; i < 16; ++i) ex[(d * 16 + i) * 64 + lane] = O[d][i] * inv;
        }
        __syncthreads();
        if (sub == 0) {
            float ss = 0.f;
#pragma unroll
            for (int d = 0; d < 4; ++d)
#pragma unroll
                for (int i = 0; i < 16; ++i) { const float o = O[d][i] * inv - lam * ex[(d * 16 + i) * 64 + lane]; O[d][i] = o; ss += o * o; }
            ss += __shfl_xor(ss, 32);
            const float rn = rsqrtf(ss * (1.0f / 128.0f) + EPS) * (1.0f - LAM_INIT);
            GAS bf16* orow = ATT + (size_t)qrow * 1024 + h * 128;
#pragma unroll
            for (int d = 0; d < 4; ++d)
#pragma unroll
                for (int g4 = 0; g4 < 4; ++g4) { const int dv = 32 * d + 8 * g4 + 4 * hh; const f32x4 sg = *(const GAS f32x4*)(INP(I_ODSUBG) + dv);
                    u32x2 o2; o2.x = pk2(O[d][4 * g4] * rn * sg[0], O[d][4 * g4 + 1] * rn * sg[1]); o2.y = pk2(O[d][4 * g4 + 2] * rn * sg[2], O[d][4 * g4 + 3] * rn * sg[3]);
                    *(GAS u32x2*)(orow + dv) = o2; }
        }
        __syncthreads();
    }
    }
    {
    const int rowk = 8 * w + (lane >> 3), ck = (lane & 7) ^ ((rowk >> 1) & 7);
    const unsigned koff = (unsigned)(rowk * 128) * 2u + ck * 16, voff = (unsigned)(rowk * KV) * 2u + ck * 16;
    const int kl = w * 1024, vl = 8192 + w * 1024;
    const int nrounds_w = (1024 + C.G - 1) / C.G;
    for (int it = 0; it < nrounds_w; ++it) {
        int unit;
        if (C.G == 256) { const int x = C.blk & 7, cix = C.blk >> 3; unit = x * 128 + it * 32 + cix; } else unit = it * C.G + C.blk;
        if (unit >= 1024) break;
        const int b = unit >> 8, kvh = (unit >> 7) & 1, q0 = (unit & 127) * 64, g = w >> 1, qh = w & 1;
        const int tq = q0 + 32 * qh + r, qrow = b * SEQ + tq;
        bf16x8 qf[4];
#pragma unroll
        for (int s = 0; s < 4; ++s) qf[s] = *(const GAS bf16x8*)(QW + (size_t)qrow * 512 + kvh * 256 + g * 64 + 16 * s + 8 * hh);
        f32x16 O[2];
#pragma unroll
        for (int d = 0; d < 2; ++d)
#pragma unroll
            for (int i = 0; i < 16; ++i) O[d][i] = 0.f;
        float m = INP(I_ODSINK)[kvh * 4 + g] * LOG2E, l = hh == 0 ? 1.0f : 0.0f; f32x16 negm;
#pragma unroll
        for (int i = 0; i < 16; ++i) negm[i] = -m;
        const int jlo_w = (q0 - 128 < 0) ? 4 + (128 - q0) / 64 : 4;
        const int jhi_w = (q0 + 192 > SEQ) ? 9 - (q0 + 192 - SEQ) / 64 : 9;
        const int ntile = 4 + (jhi_w - jlo_w);
        const GAS uchar* kbase = WK + ((size_t)b * KV * 128 + kvh * 64) * 2;
        const GAS uchar* vbase = WVT + ((size_t)(b * 128 + kvh * 64) * KV) * 2;
#define WIN_P0(i) ((i) < 4 ? 64 * (i) : CTX + q0 - 128 + 64 * ((i) - 4 + jlo_w - 4))
#define WIN_ISSUE(i, Bn) do { const int p0_ = WIN_P0(i); const GAS uchar* kg_ = kbase + (size_t)p0_ * 256; const GAS uchar* vg_ = vbase + p0_ * 2; asm volatile("" : "+s"(kg_), "+s"(vg_)); glds16(kg_ + koff, (Bn) + kl); glds16(vg_ + voff, (Bn) + vl); } while (0)
        WIN_ISSUE(0, C.lds);
        ATT_WAIT_BAR();
#pragma unroll 1
        for (int i = 0; i < ntile; ++i) {
            if (i + 1 < ntile) { LAS uchar* Bn = C.lds + ((i + 1) & 1) * WBUF; WIN_ISSUE(i + 1, Bn); }
            const LAS uchar* B = C.lds + (i & 1) * WBUF;
            if (i >= 4) attn_tile<2, true, false>(B, 0, B + 8192, qf, O, m, negm, l, r, hh, tq, WIN_P0(i) - CTX, false);
            else attn_tile<2, false, false>(B, 0, B + 8192, qf, O, m, negm, l, r, hh, 0, 0, false);
            ATT_WAIT_BAR();
        }
#undef WIN_P0
#undef WIN_ISSUE
        const float inv = 1.0f / (l + __shfl_xor(l, 32));
        GAS bf16* orow = ATT + (size_t)qrow * 1024 + 512 + kvh * 256 + g * 64;
#pragma unroll
        for (int d = 0; d < 2; ++d)
#pragma unroll
            for (int g4 = 0; g4 < 4; ++g4) { const int dv = 32 * d + 8 * g4 + 4 * hh;
                u32x2 o2; o2.x = pk2(O[d][4 * g4] * inv, O[d][4 * g4 + 1] * inv); o2.y = pk2(O[d][4 * g4 + 2] * inv, O[d][4 * g4 + 3] * inv);
                *(GAS u32x2*)(orow + dv) = o2; }
    }
    }
    __syncthreads();
}
constexpr int N_PHASES = 25;
#define XB_TMO      128
#define XB_XCNT(j)  (256  + 64 * (j))
#define XB_XSUB(j)  (1280 + 64 * (j))
#define XB_XGEN(j)  (2304 + 64 * (j))
#define XB_TOP      3328
#define XB_TOPGEN   3392
#define XCD_BAR_WORDS 3456
#define XB_SPIN_CAP (1u << 18)

__device__ __forceinline__ unsigned xb_ld(unsigned* p)              { return __hip_atomic_load(p, __ATOMIC_RELAXED, __HIP_MEMORY_SCOPE_AGENT); }
__device__ __forceinline__ unsigned xb_add(unsigned* p, unsigned v) { return __hip_atomic_fetch_add(p, v, __ATOMIC_RELAXED, __HIP_MEMORY_SCOPE_AGENT); }
__device__ __forceinline__ unsigned xb_xcc_id() { return (unsigned)__builtin_amdgcn_s_getreg((3 << 11) | 20) & 0xFu; }
#define XB_SPIN(cond, bar) do { unsigned _sp = 0; while (cond) { __builtin_amdgcn_s_sleep(1); \
    if ((++_sp & 255u) == 0u) { if (xb_ld(&(bar)[XB_TMO])) break; if (_sp > XB_SPIN_CAP) { atomicAdd(&(bar)[XB_TMO], 1u); break; } } } } while (0)

struct XcdBarrier {
    unsigned* bar; unsigned x;
    volatile LAS unsigned* st;
};

__device__ __forceinline__ XcdBarrier xcd_barrier_post(unsigned* bar, volatile LAS unsigned* st) {
    XcdBarrier b; b.bar = bar; b.x = xb_xcc_id(); b.st = st;
    if (threadIdx.x == 0) (void)xb_add(&bar[XB_XCNT(b.x)], 1u);
    return b;
}
__device__ __forceinline__ void xcd_barrier_complete(unsigned* bar, unsigned x, unsigned& nloc, unsigned& nx) {
    const unsigned G = gridDim.x * gridDim.y * gridDim.z;
    unsigned sum, cnt, mine, sp = 0u;
    for (;;) {
        sum = 0u; cnt = 0u; mine = 0u;
#pragma unroll
        for (unsigned j = 0; j < 16; ++j) { const unsigned c = xb_ld(&bar[XB_XCNT(j)]); sum += c; cnt += (c > 0u) ? 1u : 0u; mine = (j == x) ? c : mine; }
        if (sum == G) break;
        __builtin_amdgcn_s_sleep(1);
        if ((++sp & 255u) == 0u) { if (xb_ld(&bar[XB_TMO])) break; if (sp > XB_SPIN_CAP) { atomicAdd(&bar[XB_TMO], 1u); break; } }
    }
    nloc = mine > 0u ? mine : 1u; nx = cnt > 0u ? cnt : 1u;
}

__device__ __forceinline__ void xcd_barrier(const XcdBarrier& b) {
    asm volatile("s_waitcnt vmcnt(0)" ::: "memory");
    __syncthreads();
    if (threadIdx.x == 0) {
        unsigned* bar = b.bar;
        __builtin_amdgcn_s_waitcnt(0);
        unsigned nloc = b.st[0], nx = b.st[1];
        if (nloc == 0u) { xcd_barrier_complete(bar, b.x, nloc, nx); b.st[0] = nloc; b.st[1] = nx; }
        const unsigned old = xb_add(&bar[XB_XSUB(b.x)], 1u);
        const unsigned gen = old / nloc;
        if (old + 1u == (gen + 1u) * nloc) {
            __builtin_amdgcn_fence(__ATOMIC_RELEASE, "agent");
            asm volatile("s_waitcnt vmcnt(0)" ::: "memory");
            const unsigned og = xb_add(&bar[XB_TOP], 1u);
            const unsigned tg = og / nx;
            if (og + 1u == (tg + 1u) * nx) xb_add(&bar[XB_TOPGEN], 1u);
            else XB_SPIN(xb_ld(&bar[XB_TOPGEN]) == tg, bar);
            __builtin_amdgcn_fence(__ATOMIC_ACQUIRE, "agent");
            xb_add(&bar[XB_XGEN(b.x)], 1u);
            asm volatile("s_waitcnt vmcnt(0)" ::: "memory");
        } else {
            XB_SPIN(xb_ld(&bar[XB_XGEN(b.x)]) == gen, bar);
            __builtin_amdgcn_fence(__ATOMIC_ACQUIRE, "agent");
            asm volatile("s_waitcnt vmcnt(0)" ::: "memory");
        }
    }
    __syncthreads();
}

namespace pg8 {
struct Order2 : StaticOrder {
    int nsplit, nMs, nNs;
    __device__ void init2(int M, int N, int G_, int c_, int nsplit_) { init(M, N, G_, c_); nsplit = nsplit_; nMs = M / BM; nNs = N / BM; }
    __device__ __forceinline__ bool next(int i, Unit& u) const {
        int pm = 0, pn = 0, ks = 0; bool ok;
        if (nsplit <= 1) { Unit t; t.pm = 0; t.pn = 0; t.ks = 0; ok = StaticOrder::next(i, t); pm = t.pm; pn = t.pn; }
        else { const int idx = i * G + c, per = nMs * nNs; ok = idx < per * nsplit; ks = idx / per; const int rem = idx % per; pm = rem % nMs; pn = rem / nMs; }
        u.pm = pm; u.pn = pn; u.ks = ks; return ok;
    }
};
}
DI unsigned long long uniform_ptr(unsigned long long v) { const unsigned lo = __builtin_amdgcn_readfirstlane((unsigned)v), hi = __builtin_amdgcn_readfirstlane((unsigned)(v >> 32)); return ((unsigned long long)hi << 32) | lo; }
#ifndef MK_ONE_LAUNCH
#define MK_ONE_LAUNCH 1
#endif

template <int ph> DI void run_phase(const Ctx& C) {
    using namespace pg8;
    GAS float* xout = (GAS float*)C.out; GAS float* cres = WSP(float, WS_CTXR);
    switch (ph) {
    case 0: phase_prep(C); break;
    case 1: phase_modred(C); break;
    case 2: phase_e(C, 0, 0, 0, 0, 0.f, 1, 0, 0, MT, INP(I_X), INP(I_CTX), nullptr, nullptr, false, false); break;
    case 5: phase_e(C, 11, 1, 0, 0, 0.5f, 1, 0, 1, MT, INP(I_X), INP(I_CTX), xout, cres, false, true); phase_dftm(C); break;
    case 10: phase_e(C, 4, 1, 0, 1, 1.0f, 1, 0, 2, MT, xout, cres, xout, cres, true, true); break;
    case 13: phase_e(C, 11, 1, 0, 2, 0.5f, 1, 1, 0, MT, xout, cres, xout, cres, true, true); break;
    case 16: phase_e(C, 11, 1, 1, 0, 0.5f, 1, 1, 1, MT, xout, cres, xout, cres, true, true); break;
    case 20: phase_e(C, 0, 1, 1, 1, 1.0f, 1, 1, 2, MX, xout, cres, WSP(float, WS_XF), cres, true, true); break;
    case 23: phase_e(C, 0, 1, 1, 2, 0.5f, 0, 0, 0, MX, WSP(float, WS_XF), cres, xout, cres, true, false); break;
    case 3: case 11: case 14: case 21: {
        const int idx = ph == 3 ? 0 : ph == 11 ? 1 : ph == 14 ? 2 : 3, M = ph == 21 ? MX : MT;
        Gemm g{(bf16_t*)WSP(bf16_t, WS_H), (bf16_t*)WSP(bf16_t, WS_W1T) + (size_t)idx * W1T_SZ, M, 2 * DFF, DM, DM}; StaticOrder S; S.init(M, 2 * DFF, C.G, C.blk);
        EpiSwiGLU E{WSP(bf16_t, WS_ACT)};
        gemm_phase<EpiSwiGLU, StaticOrder, true, true>(C.lds, g, S, E);
    } break;
    case 4: case 12: case 15: case 22: case 9: case 19: case 8: {
        const int nrep = (ph == 19 || ph == 22) ? 1 : 2;
#pragma unroll 1
        for (int rep = 0; rep < nrep; ++rep) {
            const bf16_t* A; const bf16_t* Bt; int M = MX, N = DM, K = DM, ld = DM, nsplit = 1;
            GAS bf16_t* O = WSP(bf16_t, WS_Y); float sc = 1.0f; int dft = 0, L = 0, rowbase = 0, slab = 0, ldc = DM;
            if (ph == 9) { A = (bf16_t*)WSP(bf16_t, WS_H); Bt = (bf16_t*)WSP(bf16_t, WS_WEVOUT); }
            else if (ph == 19) { A = (bf16_t*)WSP(bf16_t, WS_H); Bt = (bf16_t*)WSP(bf16_t, WS_WODOUT); }
            else if (ph == 8) { A = (bf16_t*)WSP(bf16_t, WS_DFTM); Bt = (bf16_t*)WSP(bf16_t, WS_BDFT); M = 4096; N = 2048; K = 4096; ld = SEQ; nsplit = 2; O = WSP(bf16_t, WS_DS); ldc = 2048; slab = 4096 * 2048; }
            else { const int idx = ph == 4 ? 0 : ph == 12 ? 1 : ph == 15 ? 2 : 3; A = (bf16_t*)WSP(bf16_t, WS_ACT); Bt = (bf16_t*)WSP(bf16_t, WS_W2T) + (size_t)idx * W2T_SZ; K = DFF; ld = DFF; }
            if (rep == 1) {
                if (ph == 8) { A = (bf16_t*)WSP(bf16_t, WS_DFTC); Bt = (bf16_t*)WSP(bf16_t, WS_BDFTC); M = CTX; K = CTX; ld = CTX; nsplit = 1; O = WSP(bf16_t, WS_H); ldc = DM; slab = 0; sc = 0.005524271728019903f; dft = 1; L = CTX; rowbase = MX; }
                else { A += (size_t)MX * ld; M = MC; nsplit = ld / 256; K = 256; O = WSP(bf16_t, WS_YS); slab = MC * DM; }
            }
            const EpiY E{O, ldc, sc, dft, L, rowbase, slab};
            const Gemm g{A, Bt, M, N, K, ld}; Order2 S; S.init2(M, N, C.G, C.blk, nsplit);
            gemm_phase<EpiY, Order2, true, true>(C.lds, g, S, E);
        }
    } break;
    case 6: {
        Gemm g{(bf16_t*)WSP(bf16_t, WS_H), (bf16_t*)WSP(bf16_t, WS_WEVIN), MT, 2048, DM, DM}; StaticOrder S; S.init(MT, 2048, C.G, C.blk);
        EpiEvIn E{WSP(bf16_t, WS_PQ), WSP(bf16_t, WS_UG)};
        gemm_phase<EpiEvIn, StaticOrder, true, true>(C.lds, g, S, E);
    } break;
    case 7: fold_tiles(C, WSP(bf16, WS_PQ), 0, SEQ, WSP(bf16, WS_BDFT), true); fold_tiles(C, WSP(bf16, WS_PQ), MX, CTX, WSP(bf16, WS_BDFTC), false); phase_conv(C); break;
    case 24: phase_unfold(C); break;
    case 17: {
        Gemm g{(bf16_t*)WSP(bf16_t, WS_H), (bf16_t*)WSP(bf16_t, WS_WODIN), MT, 2304, DM, DM}; StaticOrder S; S.init(MT, 2304, C.G, C.blk);
        EpiOdIn E{WSP(bf16_t, WS_QD), WSP(bf16_t, WS_QW), WSP(bf16_t, WS_DK), WSP(bf16_t, WS_DVT), WSP(bf16_t, WS_WK), WSP(bf16_t, WS_WVT), WSP(const f32x2_t, WS_ROPE)};
        gemm_phase<EpiOdIn, StaticOrder, true, true>(C.lds, g, S, E);
    } break;
    case 18: phase_attn(C); break;
    default: break;
    }
}

__global__ void __launch_bounds__(512, 2) fwd_kernel(Args a) {
    extern __shared__ __attribute__((aligned(16))) unsigned char lds_raw[];
    Ctx C;
    C.lds = (LAS uchar*)lds_raw; C.tid = threadIdx.x; C.lane = C.tid & 63; C.wave = __builtin_amdgcn_readfirstlane(C.tid >> 6);
    C.G = gridDim.x; C.blk = blockIdx.x; C.in = a.in; C.out = a.out; C.ws = a.ws;
    const int lo_ = a.ph_lo, hi_ = a.ph_hi;
    volatile LAS unsigned* bar_st = (volatile LAS unsigned*)((LAS uchar*)lds_raw + 131072 + 352);
    if (threadIdx.x < 2) bar_st[threadIdx.x] = 0u;
    __syncthreads();
    const XcdBarrier xbar = xcd_barrier_post((unsigned*)a.ws, bar_st);
#define PHASE(k, dosync) if (lo_ <= (k) && (k) < hi_) { \
        { int t = threadIdx.x, g = gridDim.x, bk = blockIdx.x; unsigned char* w = a.ws; float* o = a.out; unsigned lo = 0; \
          asm volatile("" : "+v"(t), "+s"(g), "+s"(bk), "+s"(w), "+s"(o), "+s"(lo)); \
          C.tid = t; C.lane = t & 63; C.wave = __builtin_amdgcn_readfirstlane(t >> 6); C.G = __builtin_amdgcn_readfirstlane(g); C.blk = __builtin_amdgcn_readfirstlane(bk); \
          C.ws = (unsigned char*)uniform_ptr((unsigned long long)w); C.out = (float*)uniform_ptr((unsigned long long)o); C.lds = (LAS uchar*)lds_raw + __builtin_amdgcn_readfirstlane(lo); } \
        run_phase<k>(C); __syncthreads(); if ((dosync) == 2) cg::this_grid().sync(); else if ((dosync) == 1) xcd_barrier(xbar); }
    PHASE(0, 1) PHASE(1, 1) PHASE(2, 1) PHASE(3, 1) PHASE(4, 1) PHASE(5, 1) PHASE(6, 1) PHASE(7, 1) PHASE(8, 1) PHASE(24, 1) PHASE(9, 1) PHASE(10, 1) PHASE(11, 1)
    PHASE(12, 1) PHASE(13, 1) PHASE(14, 1) PHASE(15, 1) PHASE(16, 1) PHASE(17, 1) PHASE(18, 1) PHASE(19, 1) PHASE(20, 1) PHASE(21, 1) PHASE(22, 1) PHASE(23, 0)
#undef PHASE
    if (a.ph_hi < 0) cg::this_grid().sync();
}

extern "C" void kernel_launch(void* const* d_in, const int* in_sizes, int n_in, void* d_out, int out_size, void* d_ws, size_t ws_size, hipStream_t stream) {
    static int grid = 0;
    if (grid == 0) {
        int dev = 0, cus = 0, per_cu = 0;
        if (hipGetDevice(&dev) != hipSuccess || hipDeviceGetAttribute(&cus, hipDeviceAttributeMultiprocessorCount, dev) != hipSuccess) { fprintf(stderr, "kernel_launch: device query failed\n"); grid = -1; return; }
        if (hipFuncSetAttribute((const void*)fwd_kernel, hipFuncAttributeMaxDynamicSharedMemorySize, LDS_BYTES) != hipSuccess) { fprintf(stderr, "kernel_launch: hipFuncSetAttribute failed\n"); grid = -1; return; }
        if (hipOccupancyMaxActiveBlocksPerMultiprocessor(&per_cu, (const void*)fwd_kernel, 512, LDS_BYTES) != hipSuccess || per_cu < 1) { fprintf(stderr, "kernel_launch: occupancy query says %d\n", per_cu); per_cu = 1; }
        (void)hipGetLastError();
        grid = cus;
        if (n_in != 21 || ws_size < WS_END) fprintf(stderr, "kernel_launch: unexpected n_in %d / ws_size %zu\n", n_in, ws_size);
    }
    if (grid < 0) return;
    if (hipMemsetAsync(d_ws, 0, 16384, stream) != hipSuccess) { fprintf(stderr, "kernel_launch: memset of the barrier words failed\n"); return; }
    Args a{};
    for (int i = 0; i < 21; ++i) a.in[i] = (const float*)d_in[i];
    a.out = (float*)d_out; a.ws = (unsigned char*)d_ws;
#if MK_ONE_LAUNCH
    a.ph_lo = 0; a.ph_hi = N_PHASES;
    void* args[] = {&a};
    hipError_t e = hipLaunchCooperativeKernel((const void*)fwd_kernel, dim3(grid), dim3(512), args, LDS_BYTES, stream);
    if (e != hipSuccess) fprintf(stderr, "cooperative launch failed: %s (grid %d)\n", hipGetErrorString(e), grid);
#else
    for (int ph = 0; ph < N_PHASES; ++ph) { a.ph_lo = ph; a.ph_hi = ph + 1; hipLaunchKernelGGL(fwd_kernel, dim3(grid), dim3(512), LDS_BYTES, stream, a); }
#endif
}
```

```cpp
#include <hip/hip_runtime.h>
#include <hip/hip_cooperative_groups.h>
#include <cstdio>
#include <cstdint>
namespace cg = cooperative_groups;
namespace pg8 {
#define PG8_LAS __attribute__((address_space(3)))
typedef unsigned short bf16_t;
typedef short bf16x8 __attribute__((ext_vector_type(8)));
typedef float f32x4 __attribute__((ext_vector_type(4)));
typedef unsigned u32x4 __attribute__((ext_vector_type(4)));
constexpr int BM = 256, BK = 64, HALF = 128, HTB = HALF * BK * 2  , STAGE_BYTES = 8 * HTB, NXCD = 8, WGM = 8;

__host__ __device__ __forceinline__ int lds_byte(int r, int c) { const int st = (r >> 4) * 2 + (c >> 5), rr = r & 15, cc = c & 31, ob = rr * 64 + cc * 2; return st * 1024 + (ob ^ (((ob >> 9) & 1) << 5)); }
__host__ __device__ __forceinline__ void stage_rc(int b, int& R, int& C) { const int st = b / 1024, sb = b % 1024, swz = sb ^ (((sb >> 9) & 1) << 5); R = (st >> 1) * 16 + swz / 64; C = (st & 1) * 32 + (swz % 64) / 2; }
__host__ __device__ __forceinline__ int perm32(int rho) { const int n = rho >> 4, i = rho & 15; return 8 * (i >> 2) + 4 * n + (i & 3); }

struct Unit { int pm, pn, ks; };
struct Gemm { const bf16_t* A; const bf16_t* Bt; int M, N, K, ld; };

struct StaticOrder {
    int nM, nN, nwg, G, c;
    __host__ __device__ void init(int M, int N, int G_, int c_) { nM = M / BM; nN = N / BM; nwg = nM * nN; G = G_; c = c_; }
    __host__ __device__ bool next(int i, Unit& u) const {
        const long L = (long)i * G + c; if (L >= nwg) return false;
        int wgid = (int)L; { const int q = nwg / NXCD, r = nwg % NXCD, xcd = wgid % NXCD, off = wgid / NXCD; wgid = (xcd < r ? xcd * (q + 1) : r * (q + 1) + (xcd - r) * q) + off; }
        const int nig = WGM * nN, gid = wgid / nig, fm = gid * WGM, gsz = (nM - fm) < WGM ? (nM - fm) : WGM;
        u.pm = fm + ((wgid % nig) % gsz); u.pn = (wgid % nig) / gsz; u.ks = 0; return true;
    }
    __device__ __forceinline__ void a_ready(const Unit&) const {}
    __device__ __forceinline__ void done(const Unit&) const {}
};
}
#define LAS __attribute__((address_space(3)))
#define GAS __attribute__((address_space(1)))
#define DI __device__ __forceinline__
typedef unsigned short bf16;
typedef unsigned char uchar;
typedef float f32x2_t __attribute__((ext_vector_type(2)));
typedef __bf16 bf16x2_t __attribute__((ext_vector_type(2)));
typedef float f32x4 __attribute__((ext_vector_type(4)));
typedef float f32x16 __attribute__((ext_vector_type(16)));
typedef unsigned u32x2 __attribute__((ext_vector_type(2)));
typedef unsigned u32x4 __attribute__((ext_vector_type(4)));
typedef short bf16x8 __attribute__((ext_vector_type(8)));
typedef short s16x4 __attribute__((ext_vector_type(4)));
#define MFMA32(a, b, c) __builtin_amdgcn_mfma_f32_32x32x16_bf16((a), (b), (c), 0, 0, 0)

DI unsigned pk2(float lo, float hi) { f32x2_t v = {lo, hi}; bf16x2_t b = __builtin_convertvector(v, bf16x2_t); return __builtin_bit_cast(unsigned, b); }
DI float bflo(unsigned w) { return __uint_as_float(w << 16); }
DI float bfhi(unsigned w) { return __uint_as_float(w & 0xffff0000u); }
DI float wave_sum(float v) {
#pragma unroll
    for (int o = 1; o < 64; o <<= 1) v += __shfl_xor(v, o);
    return v;
}
DI float sigm(float x) { return __builtin_amdgcn_rcpf(1.0f + __builtin_amdgcn_exp2f(-1.4426950408889634f * x)); }
DI float silu(float x) { return x * sigm(x); }

constexpr int DM = 1024, NB = 4, SEQ = 8192, CTX = 256, DFF = 2816;
constexpr int MX = NB * SEQ;
constexpr int MC = NB * CTX;
constexpr int MT = MX + MC;
constexpr int KV = CTX + SEQ;
constexpr float EPS = 1e-6f;
constexpr float LOG2E = 1.4426950408889634f;
constexpr float LAM_INIT = 0.35550906759096926f;

constexpr size_t MiB = 1u << 20;
constexpr size_t WS_ALTP = 2 * MiB;
constexpr size_t WS_MODP = 10 * MiB  , WS_MOD = 4 * MiB, WS_ROPE = 5 * MiB, WS_COST = 5 * MiB + 65536, WS_NSIN = 5 * MiB + 2 * 65536, WS_CTXR = 6 * MiB;
constexpr size_t WS_W1T = 16 * MiB, WS_W2T = 60 * MiB, WS_WEVIN = 82 * MiB, WS_WEVOUT = 86 * MiB, WS_WODIN = 88 * MiB, WS_WODOUT = 93 * MiB, WS_DFTC = 95 * MiB;
constexpr size_t WS_H = 96 * MiB, WS_Y = 162 * MiB, WS_BIG = 228 * MiB;
constexpr size_t WS_ACT = WS_BIG;
constexpr size_t WS_PQ = WS_BIG, WS_UG = 294 * MiB, WS_BDFT = 327 * MiB, WS_BDFTC = 359 * MiB, WS_DFTM = 360 * MiB;
constexpr size_t WS_DS = 424 * MiB;
constexpr size_t WS_QD = WS_BIG, WS_QW = 260 * MiB, WS_DK = 292 * MiB, WS_DVT = 325 * MiB, WS_WK = 358 * MiB, WS_WVT = 367 * MiB;
constexpr size_t WS_XF = 410 * MiB;
constexpr size_t WS_YS = 488 * MiB;
constexpr size_t WS_END = 510 * MiB;
constexpr size_t W1T_SZ = (size_t)2 * DFF * DM, W2T_SZ = (size_t)DM * DFF;

constexpr int LDS_BYTES = 147456;

struct Args { const float* in[21]; float* out; unsigned char* ws; int ph_lo, ph_hi; };
enum { I_X = 0, I_C, I_CTX, I_CCTX, I_WMOD, I_BMOD, I_NPRE, I_NPOST, I_FWIN, I_FWOUT, I_EVWIN, I_EVCW, I_EVCB, I_EVLNG, I_EVLNB, I_EVWOUT, I_ODWIN, I_ODLAM, I_ODSUBG, I_ODSINK, I_ODWOUT };

namespace pg8 {
struct EpiY {
    static constexpr bool PERM = true, AFTER_DRAIN = false;
    GAS bf16_t* O; int ldc; float sc; int dft; int L; int rowbase; int slab;
    __device__ __forceinline__ void operator()(const f32x4 (&acc)[2][2][4][2], const Unit& u, int wr, int wc, int fr, int fq) const {
        const int row0 = u.pm * BM + wr * 64 + fr;
        GAS bf16_t* base; int colt;
        if (dft) { base = O + (size_t)(rowbase + (u.pn >> 1) * L) * ldc + (u.pn & 1) * 256; colt = 0; } else { base = O + (size_t)u.ks * slab; colt = u.pn * BM; }
        const int col0 = colt + wc * 32 + 8 * fq;
#pragma unroll
        for (int ai = 0; ai < 2; ++ai)
#pragma unroll
            for (int m = 0; m < 4; ++m) { GAS bf16_t* rowp = base + (size_t)(row0 + ai * HALF + m * 16) * ldc + col0;
#pragma unroll
                for (int bj = 0; bj < 2; ++bj) { const f32x4 v0 = acc[ai][bj][m][0] * sc, v1 = acc[ai][bj][m][1] * sc;
                    u32x4 w; w.x = pk2(v0[0], v0[1]); w.y = pk2(v0[2], v0[3]); w.z = pk2(v1[0], v1[1]); w.w = pk2(v1[2], v1[3]);
                    *(GAS u32x4*)(rowp + bj * HALF) = w; } }
    }
};
struct EpiSwiGLU {
    static constexpr bool PERM = true, AFTER_DRAIN = false;
    GAS bf16_t* O;
    __device__ __forceinline__ void operator()(const f32x4 (&acc)[2][2][4][2], const Unit& u, int wr, int wc, int fr, int fq) const {
        const int row0 = u.pm * BM + wr * 64 + fr, col0 = u.pn * HALF + wc * 32 + 8 * fq;
#pragma unroll
        for (int ai = 0; ai < 2; ++ai)
#pragma unroll
            for (int m = 0; m < 4; ++m) { GAS bf16_t* rowp = O + (size_t)(row0 + ai * HALF + m * 16) * DFF + col0;
                const f32x4 g0 = acc[ai][0][m][0], g1 = acc[ai][0][m][1], u0 = acc[ai][1][m][0], u1 = acc[ai][1][m][1];
                u32x4 w; w.x = pk2(silu(g0[0]) * u0[0], silu(g0[1]) * u0[1]); w.y = pk2(silu(g0[2]) * u0[2], silu(g0[3]) * u0[3]);
                w.z = pk2(silu(g1[0]) * u1[0], silu(g1[1]) * u1[1]); w.w = pk2(silu(g1[2]) * u1[2], silu(g1[3]) * u1[3]);
                *(GAS u32x4*)rowp = w; }
    }
};
struct EpiEvIn {
    static constexpr bool PERM = true, AFTER_DRAIN = false;
    GAS bf16_t* PQ; GAS bf16_t* UG;
    __device__ __forceinline__ void operator()(const f32x4 (&acc)[2][2][4][2], const Unit& u, int wr, int wc, int fr, int fq) const {
        const int row0 = u.pm * BM + wr * 64 + fr;
        if (u.pn < 4) {
            const int col0 = u.pn * BM + wc * 32 + 8 * fq;
#pragma unroll
            for (int ai = 0; ai < 2; ++ai)
#pragma unroll
                for (int m = 0; m < 4; ++m) { GAS bf16_t* rowp = PQ + (size_t)(row0 + ai * HALF + m * 16) * 1024 + col0;
#pragma unroll
                    for (int bj = 0; bj < 2; ++bj) { const f32x4 v0 = acc[ai][bj][m][0], v1 = acc[ai][bj][m][1];
                        u32x4 w; w.x = pk2(v0[0], v0[1]); w.y = pk2(v0[2], v0[3]); w.z = pk2(v1[0], v1[1]); w.w = pk2(v1[2], v1[3]);
                        *(GAS u32x4*)(rowp + bj * HALF) = w; } }
        } else {
            const int col0 = (u.pn - 4) * HALF + wc * 32 + 8 * fq;
#pragma unroll
            for (int ai = 0; ai < 2; ++ai)
#pragma unroll
                for (int m = 0; m < 4; ++m) { GAS bf16_t* rowp = UG + (size_t)(row0 + ai * HALF + m * 16) * 512 + col0;
                    const f32x4 a0 = acc[ai][0][m][0], a1 = acc[ai][0][m][1], g0 = acc[ai][1][m][0], g1 = acc[ai][1][m][1];
                    u32x4 w; w.x = pk2(a0[0] * sigm(g0[0]), a0[1] * sigm(g0[1])); w.y = pk2(a0[2] * sigm(g0[2]), a0[3] * sigm(g0[3]));
                    w.z = pk2(a1[0] * sigm(g1[0]), a1[1] * sigm(g1[1])); w.w = pk2(a1[2] * sigm(g1[2]), a1[3] * sigm(g1[3]));
                    *(GAS u32x4*)rowp = w; }
        }
    }
};
struct EpiOdIn {
    static constexpr bool PERM = false, AFTER_DRAIN = false;
    GAS bf16_t *QD, *QW, *DK, *DVT, *WK, *WVT; const GAS f32x2_t* rope;
    __device__ __forceinline__ void operator()(const f32x4 (&acc)[2][2][4][2], const Unit& u, int wr, int wc, int fr, int fq) const {
        const bool isx = (u.pm * BM) < MX;
        const int axis = wc & 1;
#pragma unroll
        for (int ai = 0; ai < 2; ++ai)
#pragma unroll
            for (int m = 0; m < 4; ++m) {
                const int r = u.pm * BM + ai * HALF + wr * 64 + m * 16 + fr;
                int b, p, t;
                if (isx) { b = r >> 13; t = r & 8191; p = CTX + t; } else { b = (r - MX) >> 8; t = 0; p = (r - MX) & 255; }
                f32x4 cs0 = {1.f, 0.f, 1.f, 0.f}, cs1 = {1.f, 0.f, 1.f, 0.f};
                if (isx) { const int pidx = axis ? (t & 63) : (t >> 6); const GAS f32x4* rp = (const GAS f32x4*)(rope + pidx * 16 + 4 * fq); cs0 = rp[0]; cs1 = rp[1]; }
                const size_t kvrow = (size_t)b * KV + p;
                const int pp = (p & ~12) | ((p & 4) << 1) | ((p & 8) >> 1);
#pragma unroll
                for (int bj = 0; bj < 2; ++bj) {
                    const int cb = u.pn * BM + bj * HALF + wc * 32;
                    f32x4 v0 = acc[ai][bj][m][0], v1 = acc[ai][bj][m][1];
                    const bool roped = (cb < 1024) || (cb >= 1536 && cb < 2176);
                    if (roped && isx) {
                        f32x4 o0, o1;
                        o0[0] = v0[0] * cs0[0] - v1[0] * cs0[1]; o1[0] = v1[0] * cs0[0] + v0[0] * cs0[1];
                        o0[1] = v0[1] * cs0[2] - v1[1] * cs0[3]; o1[1] = v1[1] * cs0[2] + v0[1] * cs0[3];
                        o0[2] = v0[2] * cs1[0] - v1[2] * cs1[1]; o1[2] = v1[2] * cs1[0] + v0[2] * cs1[1];
                        o0[3] = v0[3] * cs1[2] - v1[3] * cs1[3]; o1[3] = v1[3] * cs1[2] + v0[3] * cs1[3];
                        v0 = o0; v1 = o1;
                    }
                    if (cb < 512 || (cb >= 1536 && cb < 2048)) { v0 = v0 * (0.125f * LOG2E); v1 = v1 * (0.125f * LOG2E); }
                    u32x2 w0, w1; w0.x = pk2(v0[0], v0[1]); w0.y = pk2(v0[2], v0[3]); w1.x = pk2(v1[0], v1[1]); w1.y = pk2(v1[2], v1[3]);
                    if (cb < 512) { if (isx) { GAS bf16_t* d = QD + (size_t)r * 512 + cb + 4 * fq; *(GAS u32x2*)d = w0; *(GAS u32x2*)(d + 16) = w1; } }
                    else if (cb < 1024) { GAS bf16_t* d = DK + kvrow * 512 + (cb - 512) + 4 * fq; *(GAS u32x2*)d = w0; *(GAS u32x2*)(d + 16) = w1; }
                    else if (cb < 1536) { GAS bf16_t* d = DVT + ((size_t)b * 512 + (cb - 1024) + 4 * fq) * KV + pp;
                        d[0] = (bf16_t)(w0.x & 0xffff); d[KV] = (bf16_t)(w0.x >> 16); d[2 * KV] = (bf16_t)(w0.y & 0xffff); d[3 * KV] = (bf16_t)(w0.y >> 16);
                        d += (size_t)16 * KV;
                        d[0] = (bf16_t)(w1.x & 0xffff); d[KV] = (bf16_t)(w1.x >> 16); d[2 * KV] = (bf16_t)(w1.y & 0xffff); d[3 * KV] = (bf16_t)(w1.y >> 16); }
                    else if (cb < 2048) { if (isx) { GAS bf16_t* d = QW + (size_t)r * 512 + (cb - 1536) + 4 * fq; *(GAS u32x2*)d = w0; *(GAS u32x2*)(d + 16) = w1; } }
                    else if (cb < 2176) { GAS bf16_t* d = WK + kvrow * 128 + (cb - 2048) + 4 * fq; *(GAS u32x2*)d = w0; *(GAS u32x2*)(d + 16) = w1; }
                    else { GAS bf16_t* d = WVT + ((size_t)b * 128 + (cb - 2176) + 4 * fq) * KV + pp;
                        d[0] = (bf16_t)(w0.x & 0xffff); d[KV] = (bf16_t)(w0.x >> 16); d[2 * KV] = (bf16_t)(w0.y & 0xffff); d[3 * KV] = (bf16_t)(w0.y >> 16);
                        d += (size_t)16 * KV;
                        d[0] = (bf16_t)(w1.x & 0xffff); d[KV] = (bf16_t)(w1.x >> 16); d[2 * KV] = (bf16_t)(w1.y & 0xffff); d[3 * KV] = (bf16_t)(w1.y >> 16); }
                }
            }
    }
};
}
namespace pg8 {
template <class Epi, class Sched, bool ALIGN_EPI = false, bool SP2 = false>
__device__ __forceinline__ void gemm_phase(PG8_LAS unsigned char* lds, const Gemm g, const Sched& S, const Epi& E) {
    int tid_ = threadIdx.x; asm volatile("" : "+v"(tid_));
    const int tid = tid_, wid = __builtin_amdgcn_readfirstlane(tid >> 6), lane = tid & 63, wr = wid >> 2, wc = wid & 3, fr = lane & 15, fq = lane >> 4;
    const int K = g.K, nt = K / BK;
    unsigned voffA[2], voffB[2];
#pragma unroll
    for (int i = 0; i < 2; ++i) { int R, C; stage_rc(tid * 16 + i * 8192, R, C); const int Rb = Epi::PERM ? ((R & ~31) + perm32(R & 31)) : R;
        voffA[i] = (unsigned)(R * g.ld + C) * 2u; voffB[i] = (unsigned)(Rb * g.ld + C) * 2u; }
    const size_t kstep = (size_t)(BK * 2);
    const size_t hstep = (size_t)HALF * g.ld * 2;
    const size_t tstep = 2 * hstep;
    const unsigned ldsw = (unsigned)wid * 1024u;
    const int aoff = lds_byte(wr * 64 + fr, fq * 8), boff = lds_byte(wc * 32 + fr, fq * 8);
#define PG8_SA(b, h) (((b) * 2 + (h)) * HTB)
#define PG8_SB(b, h) ((4 + (b) * 2 + (h)) * HTB)
#define PG8_STAGE(bufoff, gbase, voff) do { _Pragma("unroll") for (int _i = 0; _i < 2; ++_i) \
        __builtin_amdgcn_global_load_lds((const unsigned*)((const char*)(gbase) + (voff)[_i]), (PG8_LAS unsigned*)(lds + (bufoff) + ldsw + _i * 8192), 16, 0, 0); } while (0)
#define PG8_LDA(dst, b, h) do { _Pragma("unroll") for (int m = 0; m < 4; ++m) _Pragma("unroll") for (int k = 0; k < 2; ++k) dst[m][k] = *(const PG8_LAS bf16x8*)(lds + PG8_SA(b, h) + aoff + m * 2048 + k * 1024); } while (0)
#define PG8_LDB(dst, b, h) do { _Pragma("unroll") for (int n = 0; n < 2; ++n) _Pragma("unroll") for (int k = 0; k < 2; ++k) dst[n][k] = *(const PG8_LAS bf16x8*)(lds + PG8_SB(b, h) + boff + n * 2048 + k * 1024); } while (0)
#define PG8_MMA(ai, bj, At, Bt) do { __builtin_amdgcn_s_setprio(1); _Pragma("unroll") for (int m = 0; m < 4; ++m) _Pragma("unroll") for (int n = 0; n < 2; ++n) _Pragma("unroll") for (int k = 0; k < 2; ++k) \
        acc[ai][bj][m][n] = __builtin_amdgcn_mfma_f32_16x16x32_bf16(Bt[n][k], At[m][k], acc[ai][bj][m][n], 0, 0, 0); __builtin_amdgcn_s_setprio(0); } while (0)
#define PG8_WAIT_V(n) asm volatile("s_waitcnt vmcnt(" #n ")" ::: "memory")
#define PG8_WAIT_L(n) asm volatile("s_waitcnt lgkmcnt(" #n ")" ::: "memory")
#define PG8_BAR __builtin_amdgcn_s_barrier()
#define PG8_SCHED __builtin_amdgcn_sched_barrier(0)
    Unit cur, nxt; int ui = 0;
    if (!S.next(0, cur)) return;
    f32x4 acc[2][2][4][2];
#pragma unroll
    for (int a = 0; a < 2; ++a)
#pragma unroll
        for (int b = 0; b < 2; ++b)
#pragma unroll
            for (int m = 0; m < 4; ++m)
#pragma unroll
                for (int n = 0; n < 2; ++n) acc[a][b][m][n] = (f32x4){0.f, 0.f, 0.f, 0.f};
    bf16x8 At[4][2], B0[2][2], B1[2][2];
    const char* cA = (const char*)g.A + (size_t)cur.pm * tstep + (size_t)cur.ks * K * 2; const char* cB = (const char*)g.Bt + (size_t)cur.pn * tstep + (size_t)cur.ks * K * 2;
    S.a_ready(cur);
    if constexpr (SP2) {
        PG8_STAGE(PG8_SB(0, 0), cB, voffB); PG8_STAGE(PG8_SB(0, 1), cB + hstep, voffB); PG8_STAGE(PG8_SA(0, 0), cA, voffA); PG8_STAGE(PG8_SA(0, 1), cA + hstep, voffA);
        if (wr == 1) PG8_BAR;
        PG8_WAIT_V(2); PG8_BAR;
        PG8_STAGE(PG8_SB(1, 0), cB + kstep, voffB); PG8_STAGE(PG8_SA(1, 0), cA + kstep, voffA); PG8_STAGE(PG8_SB(1, 1), cB + hstep + kstep, voffB);
        PG8_WAIT_V(6); PG8_BAR;
    } else {
        PG8_STAGE(PG8_SB(0, 0), cB, voffB); PG8_STAGE(PG8_SA(0, 0), cA, voffA); PG8_STAGE(PG8_SB(0, 1), cB + hstep, voffB); PG8_STAGE(PG8_SA(0, 1), cA + hstep, voffA);
        if (wr == 1) PG8_BAR;
        PG8_WAIT_V(4); PG8_BAR;
        PG8_STAGE(PG8_SB(1, 0), cB + kstep, voffB); PG8_STAGE(PG8_SA(1, 0), cA + kstep, voffA); PG8_STAGE(PG8_SB(1, 1), cB + hstep + kstep, voffB);
        PG8_WAIT_V(6); PG8_BAR;
    }
    for (;;) {
        const bool has_next = S.next(ui + 1, nxt);
        const char* nA = has_next ? (const char*)g.A + (size_t)nxt.pm * tstep + (size_t)nxt.ks * K * 2 : cA; const char* nB = has_next ? (const char*)g.Bt + (size_t)nxt.pn * tstep + (size_t)nxt.ks * K * 2 : cB;
        for (int t = 0; t < nt; t += 2) {
            const bool last = (t == nt - 2);
            const char* a1 = cA + (size_t)(t + 1) * kstep;
            const char* a2 = last ? nA : cA + (size_t)(t + 2) * kstep; const char* b2 = last ? nB : cB + (size_t)(t + 2) * kstep;
            const char* a3 = a2 + kstep; const char* b3 = b2 + kstep;
            if (last && has_next) S.a_ready(nxt);
            if constexpr (SP2) {
            PG8_LDB(B0, 0, 0); PG8_LDB(B1, 0, 1); PG8_SCHED; PG8_LDA(At, 0, 0); PG8_STAGE(PG8_SA(1, 1), a1 + hstep, voffA);
            PG8_WAIT_V(8); PG8_WAIT_L(0); PG8_BAR; PG8_MMA(0, 0, At, B0); PG8_MMA(0, 1, At, B1); PG8_BAR; PG8_SCHED;
            PG8_LDA(At, 0, 1); PG8_STAGE(PG8_SB(0, 0), b2, voffB); PG8_STAGE(PG8_SB(0, 1), b2 + hstep, voffB); PG8_STAGE(PG8_SA(0, 0), a2, voffA);
            PG8_WAIT_V(8); PG8_WAIT_L(0); PG8_BAR; PG8_MMA(1, 0, At, B0); PG8_MMA(1, 1, At, B1); PG8_BAR; PG8_SCHED;
            PG8_LDB(B0, 1, 0); PG8_LDB(B1, 1, 1); PG8_SCHED; PG8_LDA(At, 1, 0); PG8_STAGE(PG8_SA(0, 1), a2 + hstep, voffA);
            PG8_WAIT_V(8); PG8_WAIT_L(0); PG8_BAR; PG8_MMA(0, 0, At, B0); PG8_MMA(0, 1, At, B1); PG8_BAR; PG8_SCHED;
            PG8_LDA(At, 1, 1); PG8_STAGE(PG8_SB(1, 0), b3, voffB); PG8_STAGE(PG8_SB(1, 1), b3 + hstep, voffB); PG8_STAGE(PG8_SA(1, 0), a3, voffA);
            PG8_WAIT_V(8); PG8_WAIT_L(0); PG8_BAR; PG8_MMA(1, 0, At, B0); PG8_MMA(1, 1, At, B1); PG8_BAR; PG8_SCHED;
            } else {
            PG8_LDB(B0, 0, 0); PG8_SCHED; PG8_LDA(At, 0, 0); PG8_STAGE(PG8_SA(1, 1), a1 + hstep, voffA);
            PG8_WAIT_L(8); PG8_BAR; PG8_WAIT_L(0); PG8_MMA(0, 0, At, B0); PG8_BAR; PG8_SCHED;
            PG8_LDB(B1, 0, 1); PG8_STAGE(PG8_SB(0, 0), b2, voffB);
            PG8_BAR; PG8_WAIT_L(0); PG8_MMA(0, 1, At, B1); PG8_BAR;
            PG8_LDA(At, 0, 1); PG8_STAGE(PG8_SA(0, 0), a2, voffA);
            PG8_BAR; PG8_WAIT_L(0); PG8_MMA(1, 0, At, B0); PG8_BAR; PG8_SCHED;
            PG8_STAGE(PG8_SB(0, 1), b2 + hstep, voffB);
            PG8_WAIT_V(6); PG8_BAR; PG8_MMA(1, 1, At, B1); PG8_BAR;
            PG8_LDB(B0, 1, 0); PG8_SCHED; PG8_LDA(At, 1, 0); PG8_STAGE(PG8_SA(0, 1), a2 + hstep, voffA);
            PG8_WAIT_L(8); PG8_BAR; PG8_WAIT_L(0); PG8_MMA(0, 0, At, B0); PG8_BAR; PG8_SCHED;
            PG8_LDB(B1, 1, 1); PG8_STAGE(PG8_SB(1, 0), b3, voffB);
            PG8_BAR; PG8_WAIT_L(0); PG8_MMA(0, 1, At, B1); PG8_BAR;
            PG8_LDA(At, 1, 1); PG8_STAGE(PG8_SA(1, 0), a3, voffA);
            PG8_BAR; PG8_WAIT_L(0); PG8_MMA(1, 0, At, B0); PG8_BAR; PG8_SCHED;
            PG8_STAGE(PG8_SB(1, 1), b3 + hstep, voffB);
            PG8_WAIT_V(6); PG8_BAR; PG8_MMA(1, 1, At, B1); PG8_BAR;
            }
        }
        if constexpr (ALIGN_EPI) { if (wr == 0) PG8_BAR; }
        if constexpr (!Epi::AFTER_DRAIN) { E(acc, cur, wr, wc, fr, fq); S.done(cur); }
        if (!has_next) break;
#pragma unroll
        for (int a = 0; a < 2; ++a)
#pragma unroll
            for (int b = 0; b < 2; ++b)
#pragma unroll
                for (int m = 0; m < 4; ++m)
#pragma unroll
                    for (int n = 0; n < 2; ++n) acc[a][b][m][n] = (f32x4){0.f, 0.f, 0.f, 0.f};
        cur = nxt; cA = nA; cB = nB; ++ui;
        if constexpr (ALIGN_EPI) { if (wr == 1) PG8_BAR; }
    }
    PG8_WAIT_V(0);
    if constexpr (!ALIGN_EPI) { if (wr == 0) PG8_BAR; }
    PG8_BAR;
    if constexpr (Epi::AFTER_DRAIN) { E.fused(acc, cur, wr, wc, fr, fq, lds, wid, lane); S.done(cur); }
#undef PG8_SA
#undef PG8_SB
#undef PG8_STAGE
#undef PG8_LDA
#undef PG8_LDB
#undef PG8_MMA
#undef PG8_WAIT_V
#undef PG8_WAIT_L
#undef PG8_BAR
#undef PG8_SCHED
}
}
struct Ctx {
    LAS uchar* lds; int tid, lane, wave, G, blk;
    const float* const* in; float* out; uchar* ws;
};
#define WSP(T, off) ((GAS T*)(C.ws + (off)))
#define INP(i) ((const GAS float*)C.in[i])

DI void transpose_item(const GAS float* W, int K, int N, GAS bf16* WT, int vrow0, int scol0, int k0, LAS float* scr, int lane) {
    float wv[32];
#pragma unroll
    for (int i = 0; i < 32; ++i) wv[i] = __builtin_nontemporal_load(W + (size_t)(k0 + 2 * i + (lane >> 5)) * N + scol0 + (lane & 31));
#pragma unroll
    for (int i = 0; i < 32; ++i) scr[(2 * i + (lane >> 5)) * 33 + (lane & 31)] = wv[i];
    asm volatile("s_waitcnt lgkmcnt(0)" ::: "memory");
    const int c = lane & 7;
#pragma unroll
    for (int j = 0; j < 4; ++j) { const int n = (lane >> 3) + 8 * j; const LAS float* s = scr + (8 * c) * 33 + n;
        u32x4 o; o.x = pk2(s[0 * 33], s[1 * 33]); o.y = pk2(s[2 * 33], s[3 * 33]); o.z = pk2(s[4 * 33], s[5 * 33]); o.w = pk2(s[6 * 33], s[7 * 33]);
        *(GAS u32x4*)(WT + (size_t)(vrow0 + n) * K + k0 + 8 * c) = o; }
    asm volatile("s_waitcnt lgkmcnt(0)" ::: "memory");
}
DI int glu_map128(int v, int half_off) { return ((v & 255) >= 128 ? half_off : 0) + 128 * (v >> 8) + (v & 127); }

DI void phase_prep(const Ctx& C) {
    LAS float* scr = (LAS float*)(C.lds + C.wave * 16384);
    const int gw = C.blk * 8 + C.wave, NGW = C.G * 8, lane = C.lane;
    constexpr int N_MODP = 2 * 16 * 36;
    constexpr int T_W1 = 4 * 16 * 176, T_W2 = 4 * 44 * 32, T_EVG = 16 * 32, T_EVO = 16 * 32, T_ODI = 16 * 72, T_ODO = 16 * 32;
    constexpr int N_TR = T_W1 + T_W2 + T_EVG + T_EVO + T_ODI + T_ODO;
    constexpr int N_PQ = 1024 * 4, N_COS = 128, N_DFTC = 1024, N_ROPE = 32;
    constexpr int TOTAL = N_MODP + N_TR + N_PQ + N_COS + N_DFTC + N_ROPE;
    for (int it0 = gw; it0 < TOTAL; it0 += NGW) {
        int it = it0;
        if (it < N_MODP) {
            const int l = it / 576, rem = it % 576, kc = rem / 36, nc = rem % 36, n0 = nc * 256 + 4 * lane;
            const GAS float* wm = INP(I_WMOD) + ((size_t)l * 1024 + kc * 64) * 9216 + n0;
            f32x4 acc[5];
#pragma unroll
            for (int i = 0; i < 5; ++i) acc[i] = (f32x4){0.f, 0.f, 0.f, 0.f};
#pragma unroll 1
            for (int k0 = 0; k0 < 64; k0 += 8) {
                f32x4 w[8];
#pragma unroll
                for (int k = 0; k < 8; ++k) w[k] = __builtin_nontemporal_load((const GAS f32x4*)(wm + (size_t)(k0 + k) * 9216));
#pragma unroll
                for (int k = 0; k < 8; ++k) { const int kk = kc * 64 + k0 + k;
#pragma unroll
                    for (int mi = 0; mi < 5; ++mi) { const float cv = mi < 4 ? INP(I_C)[mi * 1024 + kk] : INP(I_CCTX)[kk]; acc[mi] += silu(cv) * w[k]; } }
            }
            GAS float* mp = WSP(float, WS_MODP);
#pragma unroll
            for (int mi = 0; mi < 5; ++mi) *(GAS f32x4*)(mp + ((size_t)(kc * 2 + l) * 5 + mi) * 9216 + n0) = acc[mi];
            continue;
        }
        it -= N_MODP;
        if (it < N_TR) {
            if (it < T_W1) { const int mat = it / (16 * 176), r = it % (16 * 176), kb = r / 176, nb = r % 176;
                transpose_item(INP(I_FWIN) + (size_t)mat * 1024 * 5632, 1024, 5632, WSP(bf16, WS_W1T) + (size_t)mat * W1T_SZ, 32 * nb, glu_map128(32 * nb, DFF), 64 * kb, scr, lane); continue; }
            it -= T_W1;
            if (it < T_W2) { const int mat = it / (44 * 32), r = it % (44 * 32), kb = r / 32, nb = r % 32;
                transpose_item(INP(I_FWOUT) + (size_t)mat * DFF * 1024, DFF, 1024, WSP(bf16, WS_W2T) + (size_t)mat * W2T_SZ, 32 * nb, 32 * nb, 64 * kb, scr, lane); continue; }
            it -= T_W2;
            if (it < T_EVG) { const int kb = it / 32, nb = it % 32;
                transpose_item(INP(I_EVWIN), 1024, 1536, WSP(bf16, WS_WEVIN), 1024 + 32 * nb, 512 + glu_map128(32 * nb, 512), 64 * kb, scr, lane); continue; }
            it -= T_EVG;
            if (it < T_EVO) { const int kb = it / 32, nb = it % 32; transpose_item(INP(I_EVWOUT), 1024, 1024, WSP(bf16, WS_WEVOUT), 32 * nb, 32 * nb, 64 * kb, scr, lane); continue; }
            it -= T_EVO;
            if (it < T_ODI) { const int kb = it / 72, nb = it % 72; transpose_item(INP(I_ODWIN), 1024, 2304, WSP(bf16, WS_WODIN), 32 * nb, 32 * nb, 64 * kb, scr, lane); continue; }
            it -= T_ODI;
            { const int kb = it / 32, nb = it % 32; transpose_item(INP(I_ODWOUT), 1024, 1024, WSP(bf16, WS_WODOUT), 32 * nb, 32 * nb, 64 * kb, scr, lane); continue; }
        }
        it -= N_TR;
        if (it < N_PQ) {
            const int k = it >> 2, g = it & 3;
            const GAS float* wa = INP(I_EVWIN) + (size_t)k * 1536 + g * 128;
            const float a0 = wa[lane], a1 = wa[64 + lane];
            float p0 = 0.f, q0 = 0.f, p1 = 0.f, q1 = 0.f;
            for (int w = 0; w < 128; ++w) {
                const float aw = __shfl(w < 64 ? a0 : a1, w & 63);
                const int mm = (w * lane) & 127; const float rev = (float)mm * (1.0f / 128.0f); const float s = __builtin_amdgcn_sinf(rev), c = __builtin_amdgcn_cosf(rev);
                const float sg = (w & 1) ? -aw : aw;
                p0 += aw * c; q0 += aw * s; p1 += sg * c; q1 += sg * s;
            }
            GAS bf16* wt = WSP(bf16, WS_WEVIN);
            wt[(size_t)(g * 128 + lane) * 1024 + k] = (bf16)(pk2(p0, 0.f) & 0xffff);
            wt[(size_t)(g * 128 + 64 + lane) * 1024 + k] = (bf16)(pk2(p1, 0.f) & 0xffff);
            wt[(size_t)(512 + g * 128 + lane) * 1024 + k] = (bf16)(pk2(q0, 0.f) & 0xffff);
            wt[(size_t)(512 + g * 128 + 64 + lane) * 1024 + k] = (bf16)(pk2(q1, 0.f) & 0xffff);
            continue;
        }
        it -= N_PQ;
        if (it < N_COS) { const int mm = it * 64 + lane; float s, c; sincospif((float)mm * (1.0f / 4096.0f), &s, &c);
            WSP(bf16, WS_COST)[mm] = (bf16)(pk2(c, 0.f) & 0xffff); WSP(bf16, WS_NSIN)[mm] = (bf16)(pk2(-s, 0.f) & 0xffff); continue; }
        it -= N_COS;
        if (it < N_DFTC) { const int idx = it * 64 + lane, j = idx >> 8, kk = idx & 255; float v;
            if (kk <= 128) v = cospif((float)((j * kk) & 255) * (1.0f / 128.0f)); else v = -sinpif((float)((j * (kk - 128)) & 255) * (1.0f / 128.0f));
            WSP(bf16, WS_DFTC)[idx] = (bf16)(pk2(v, 0.f) & 0xffff); continue; }
        it -= N_DFTC;
        { const int idx = it * 64 + lane, p = idx >> 4, i = idx & 15; const float inv = powf(10000.0f, -(float)i * (1.0f / 16.0f)); const float ang = (float)p * inv;
            f32x2_t cs; cs.x = cosf(ang); cs.y = sinf(ang); WSP(f32x2_t, WS_ROPE)[idx] = cs; }
    }
}

DI void phase_modred(const Ctx& C) {
    const GAS float* mp = WSP(float, WS_MODP); GAS float* mo = WSP(float, WS_MOD);
    for (int idx = C.blk * 512 + C.tid; idx < 2 * 5 * 9216; idx += C.G * 512) {
        const int l = idx / 46080, rem = idx % 46080, mi = rem / 9216, n = rem % 9216;
        float s = INP(I_BMOD)[l * 9216 + n];
#pragma unroll
        for (int kc = 0; kc < 16; ++kc) s += mp[((size_t)(kc * 2 + l) * 5 + mi) * 9216 + n];
        mo[idx] = s;
    }
}

DI void phase_e(const Ctx& C, int nslab, int has_post, int pl, int ps, float pw, int has_pre, int ql, int qs, int nrows,
                const GAS float* xsrc, const GAS float* csrc, GAS float* xdst, GAS float* cdst, bool xs16, bool xd16) {
    const int lane = C.lane;
    const int xpb = (MX + C.G - 1) / C.G, cpb = nrows > MX ? (MC + C.G - 1) / C.G : 0, total = xpb + cpb;
    const GAS float* mod = WSP(float, WS_MOD); const GAS bf16* Y = WSP(bf16, WS_Y); const GAS bf16* YS = WSP(bf16, WS_YS); GAS bf16* H = WSP(bf16, WS_H);
    f32x4 gpo[4], gpr[4], gt[4], sc[4], sh[4]; int cur = -1;
#pragma unroll
    for (int j = 0; j < 4; ++j) {
        gpo[j] = has_post ? *(const GAS f32x4*)(INP(I_NPOST) + (pl * 3 + ps) * 1024 + 256 * j + 4 * lane) : (f32x4){0.f, 0.f, 0.f, 0.f};
        gpr[j] = has_pre ? *(const GAS f32x4*)(INP(I_NPRE) + (ql * 3 + qs) * 1024 + 256 * j + 4 * lane) : (f32x4){0.f, 0.f, 0.f, 0.f};
        gt[j] = sc[j] = sh[j] = (f32x4){0.f, 0.f, 0.f, 0.f};
    }
    f32x4 vN[4], vM[4]; u32x2 yN[4], yM[4];
#define E_ROW(i) ((i) < xpb ? C.blk * xpb + (i) : MX + C.blk * cpb + ((i) - xpb))
#define E_LOAD(i, V, Yw) do { const int row_ = E_ROW(i); const bool isx_ = row_ < MX; \
        if (isx_ && xs16) { const GAS bf16* s16_ = (const GAS bf16*)xsrc + (size_t)row_ * 1024; \
            _Pragma("unroll") for (int j = 0; j < 4; ++j) { const u32x2 w_ = __builtin_nontemporal_load((const GAS u32x2*)(s16_ + 256 * j + 4 * lane)); V[j] = (f32x4){bflo(w_.x), bfhi(w_.x), bflo(w_.y), bfhi(w_.y)}; } } \
        else { const GAS float* src_ = isx_ ? xsrc + (size_t)row_ * 1024 : csrc + (size_t)(row_ - MX) * 1024; \
            _Pragma("unroll") for (int j = 0; j < 4; ++j) V[j] = __builtin_nontemporal_load((const GAS f32x4*)(src_ + 256 * j + 4 * lane)); } \
        if (has_post && (isx_ || nslab == 0)) { _Pragma("unroll") for (int j = 0; j < 4; ++j) Yw[j] = __builtin_nontemporal_load((const GAS u32x2*)(Y + (size_t)row_ * 1024 + 256 * j + 4 * lane)); } } while (0)
    int i = C.wave;
    if (i < total) E_LOAD(i, vN, yN);
    if (i + 8 < total) E_LOAD(i + 8, vM, yM);
    for (; i < total; i += 8) {
        const int row = E_ROW(i);
        const bool isx = row < MX; const int mi = isx ? (row >> 13) : 4;
        f32x4 v[4]; u32x2 yw[4];
#pragma unroll
        for (int j = 0; j < 4; ++j) { v[j] = vN[j]; yw[j] = yN[j]; vN[j] = vM[j]; yN[j] = yM[j]; }
        if (i + 16 < total) E_LOAD(i + 16, vM, yM);
        if (mi != cur) { cur = mi;
#pragma unroll
            for (int j = 0; j < 4; ++j) {
                if (has_post) gt[j] = *(const GAS f32x4*)(mod + (size_t)(pl * 5 + mi) * 9216 + (3 * ps + 2) * 1024 + 256 * j + 4 * lane);
                if (has_pre) { sc[j] = *(const GAS f32x4*)(mod + (size_t)(ql * 5 + mi) * 9216 + (3 * qs + 1) * 1024 + 256 * j + 4 * lane);
                               sh[j] = *(const GAS f32x4*)(mod + (size_t)(ql * 5 + mi) * 9216 + (3 * qs) * 1024 + 256 * j + 4 * lane); }
            } }
        if (has_post) {
            f32x4 y[4]; float ss = 0.f;
#pragma unroll
            for (int j = 0; j < 4; ++j) {
                if (isx || nslab == 0) { y[j] = (f32x4){bflo(yw[j].x), bfhi(yw[j].x), bflo(yw[j].y), bfhi(yw[j].y)}; }
                else { y[j] = (f32x4){0.f, 0.f, 0.f, 0.f};
                    for (int s = 0; s < nslab; ++s) { const u32x2 w = *(const GAS u32x2*)(YS + ((size_t)s * MC + (row - MX)) * 1024 + 256 * j + 4 * lane); y[j] += (f32x4){bflo(w.x), bfhi(w.x), bflo(w.y), bfhi(w.y)}; } }
                ss += (y[j][0] * y[j][0] + y[j][1] * y[j][1]) + (y[j][2] * y[j][2] + y[j][3] * y[j][3]); }
            const float r = rsqrtf(wave_sum(ss) * (1.0f / 1024.0f) + EPS);
            if (isx && xd16) { GAS bf16* d16 = (GAS bf16*)xdst + (size_t)row * 1024;
#pragma unroll
                for (int j = 0; j < 4; ++j) { v[j] += pw * gt[j] * ((y[j] * r) * gpo[j]); u32x2 w; w.x = pk2(v[j][0], v[j][1]); w.y = pk2(v[j][2], v[j][3]); __builtin_nontemporal_store(w, (GAS u32x2*)(d16 + 256 * j + 4 * lane));
                    v[j] = (f32x4){bflo(w.x), bfhi(w.x), bflo(w.y), bfhi(w.y)}; }
            } else { GAS float* dst = isx ? xdst + (size_t)row * 1024 : cdst + (size_t)(row - MX) * 1024;
#pragma unroll
                for (int j = 0; j < 4; ++j) { v[j] += pw * gt[j] * ((y[j] * r) * gpo[j]); __builtin_nontemporal_store(v[j], (GAS f32x4*)(dst + 256 * j + 4 * lane)); } }
        }
        if (has_pre) {
            float ss = 0.f;
#pragma unroll
            for (int j = 0; j < 4; ++j) ss += (v[j][0] * v[j][0] + v[j][1] * v[j][1]) + (v[j][2] * v[j][2] + v[j][3] * v[j][3]);
            const float r = rsqrtf(wave_sum(ss) * (1.0f / 1024.0f) + EPS);
#pragma unroll
            for (int j = 0; j < 4; ++j) { const f32x4 h = ((v[j] * r) * gpr[j]) * (1.0f + sc[j]) + sh[j];
                u32x2 w; w.x = pk2(h[0], h[1]); w.y = pk2(h[2], h[3]); *(GAS u32x2*)(H + (size_t)row * 1024 + 256 * j + 4 * lane) = w; }
        }
    }
#undef E_ROW
#undef E_LOAD
}

DI void phase_dftm(const Ctx& C) {
    GAS bf16* D = WSP(bf16, WS_DFTM);
    for (int ch = C.blk * 512 + C.tid; ch < 4096 * 1024; ch += C.G * 512) {
        const int j = ch >> 10, kc = ch & 1023;
        float e[8];
#pragma unroll
        for (int i = 0; i < 8; ++i) { const int kk = 8 * kc + i;
            const float rev = (float)((j * (kk & 4095)) & 8191) * (1.0f / 8192.0f);
            e[i] = (kk < 4096) ? __builtin_amdgcn_cosf(rev) : __builtin_amdgcn_sinf(rev); }
        u32x4 w; w.x = pk2(e[0], e[1]); w.y = pk2(e[2], e[3]); w.z = pk2(e[4], e[5]); w.w = pk2(e[6], e[7]);
        *(GAS u32x4*)(D + (size_t)ch * 8) = w;
    }
}
DI void phase_unfold(const Ctx& C) {
    const GAS bf16* DS = WSP(bf16, WS_DS); const GAS bf16* PQ = WSP(bf16, WS_PQ); GAS bf16* MIX = WSP(bf16, WS_H);
    constexpr size_t SL = (size_t)4096 * 2048; constexpr float SC = 1.0f / 1024.0f;
    for (int it = C.blk * 512 + C.tid; it < 4096 * 256; it += C.G * 512) {
        const int j = it >> 8, n = (it & 255) * 8, b = n >> 9, ch = n & 511;
        const u32x4 c = *(const GAS u32x4*)(DS + (size_t)j * 2048 + n), s = *(const GAS u32x4*)(DS + SL + (size_t)j * 2048 + n);
        const u32x4 e = *(const GAS u32x4*)(PQ + ((size_t)b * SEQ + 4096) * 1024 + ch);
        const float sg = (j & 1) ? -1.0f : 1.0f;
        const unsigned cw[4] = {c.x, c.y, c.z, c.w}, sw[4] = {s.x, s.y, s.z, s.w}, ew[4] = {e.x, e.y, e.z, e.w};
        unsigned o1[4], o2[4];
#pragma unroll
        for (int q = 0; q < 4; ++q) { const float c0 = bflo(cw[q]) + sg * bflo(ew[q]), c1 = bfhi(cw[q]) + sg * bfhi(ew[q]), s0 = bflo(sw[q]), s1 = bfhi(sw[q]);
            o1[q] = pk2((c0 - s0) * SC, (c1 - s1) * SC); o2[q] = pk2((c0 + s0) * SC, (c1 + s1) * SC); }
        *(GAS u32x4*)(MIX + ((size_t)b * SEQ + j) * 1024 + ch) = (u32x4){o1[0], o1[1], o1[2], o1[3]};
        if (j > 0) *(GAS u32x4*)(MIX + ((size_t)b * SEQ + SEQ - j) * 1024 + ch) = (u32x4){o2[0], o2[1], o2[2], o2[3]};
    }
    const GAS float* AP = WSP(float, WS_ALTP);
    for (int idx = C.blk * 512 + C.tid; idx < 4 * 512; idx += C.G * 512) {
        const int b = idx >> 9, ch = idx & 511; float t = 0.f;
#pragma unroll 8
        for (int r = 0; r < 64; ++r) t += AP[(size_t)(b * 64 + r) * 512 + ch];
        MIX[((size_t)b * SEQ + 4096) * 1024 + ch] = (bf16)(pk2(t * SC, 0.f) & 0xffff);
    }
}

DI void fold_tiles(const Ctx& C, const GAS bf16* PQ, int rowbase, int L, GAS bf16* Bt, bool jf) {
    LAS bf16* sm = (LAS bf16*)C.lds;
    const int nkb = L / 64, ntiles = 8 * nkb, half = L / 2;
    const int rl = C.tid >> 3, c8 = C.tid & 7;
    for (int tile = C.blk; tile < ntiles; tile += C.G) {
        const int nb = tile / nkb, kb = tile % nkb, n0 = nb * 256, b = n0 >> 9, ch0 = n0 & 511, kk = kb * 64 + rl;
        int colb, l1, l2; bool has2; float sg, sa = 1.f;
        if (jf) {
            if (kk < half) { colb = ch0; l1 = kk; l2 = L - kk; has2 = (kk != 0); sg = 1.f; }
            else { colb = 512 + ch0; l1 = kk - half; l2 = L - l1; has2 = (kk != half); sg = -1.f; if (kk == half) sa = 0.f; }
        } else {
            if (kk <= half) { colb = ch0; l1 = kk; l2 = L - kk; has2 = (kk != 0 && kk != half); sg = 1.f; }
            else { colb = 512 + ch0; l1 = kk - half; l2 = L - l1; has2 = true; sg = -1.f; }
        }
        if (!has2) { l2 = l1; sg = 0.f; }
        u32x4 a[4], bb[4];
#pragma unroll
        for (int q = 0; q < 4; ++q) { a[q] = *(const GAS u32x4*)(PQ + (size_t)(rowbase + b * L + l1) * 1024 + colb + 64 * q + 8 * c8);
                                      bb[q] = *(const GAS u32x4*)(PQ + (size_t)(rowbase + b * L + l2) * 1024 + colb + 64 * q + 8 * c8); }
#pragma unroll
        for (int q = 0; q < 4; ++q) {
            float f[8];
            f[0] = sa * bflo(a[q].x) + sg * bflo(bb[q].x); f[1] = sa * bfhi(a[q].x) + sg * bfhi(bb[q].x); f[2] = sa * bflo(a[q].y) + sg * bflo(bb[q].y); f[3] = sa * bfhi(a[q].y) + sg * bfhi(bb[q].y);
            f[4] = sa * bflo(a[q].z) + sg * bflo(bb[q].z); f[5] = sa * bfhi(a[q].z) + sg * bfhi(bb[q].z); f[6] = sa * bflo(a[q].w) + sg * bflo(bb[q].w); f[7] = sa * bfhi(a[q].w) + sg * bfhi(bb[q].w);
#pragma unroll
            for (int i = 0; i < 8; ++i) sm[(64 * q + 8 * c8 + i) * 72 + rl] = (bf16)(pk2(f[i], 0.f) & 0xffff);
        }
        __syncthreads();
#pragma unroll
        for (int q = 0; q < 4; ++q) { const u32x4 o = *(const LAS u32x4*)(sm + (64 * q + rl) * 72 + 8 * c8);
            *(GAS u32x4*)(Bt + (size_t)(n0 + 64 * q + rl) * L + kb * 64 + 8 * c8) = o; }
        __syncthreads();
    }
}
DI void altsum_partials(const Ctx& C) {
    const GAS bf16* PQ = WSP(bf16, WS_PQ); GAS float* AP = WSP(float, WS_ALTP);
    LAS float* red = (LAS float*)C.lds;
    for (int item = C.blk; item < 256; item += C.G) {
        const int b = item >> 6, r0 = (item & 63) * 128;
        float acc[8];
#pragma unroll
        for (int i = 0; i < 8; ++i) acc[i] = 0.f;
        u32x4 p[16];
#pragma unroll
        for (int i = 0; i < 16; ++i) p[i] = *(const GAS u32x4*)(PQ + ((size_t)b * SEQ + r0 + C.wave + 8 * i) * 1024 + 8 * C.lane);
#pragma unroll
        for (int i = 0; i < 16; ++i) { acc[0] += bflo(p[i].x); acc[1] += bfhi(p[i].x); acc[2] += bflo(p[i].y); acc[3] += bfhi(p[i].y); acc[4] += bflo(p[i].z); acc[5] += bfhi(p[i].z); acc[6] += bflo(p[i].w); acc[7] += bfhi(p[i].w); }
        const float sg = (C.wave & 1) ? -1.0f : 1.0f;
#pragma unroll
        for (int i = 0; i < 8; ++i) red[(C.wave * 64 + C.lane) * 8 + i] = acc[i] * sg;
        __syncthreads();
        { float t = 0.f;
#pragma unroll
          for (int wv = 0; wv < 8; ++wv) t += red[wv * 512 + C.tid];
          AP[(size_t)item * 512 + C.tid] = t; }
        __syncthreads();
    }
}
DI void phase_conv(const Ctx& C) {
    LAS float* cw = (LAS float*)(C.lds + 16384);
    for (int i = C.tid; i < 31 * 512; i += 512) cw[i] = INP(I_EVCW)[i];
    __syncthreads();
    const GAS bf16* UG = WSP(bf16, WS_UG); GAS bf16* MIX = WSP(bf16, WS_H);
    const int lane = C.lane, c0 = 8 * lane;
    f32x4 bias0 = *(const GAS f32x4*)(INP(I_EVCB) + c0), bias1 = *(const GAS f32x4*)(INP(I_EVCB) + c0 + 4);
    f32x4 lg0 = *(const GAS f32x4*)(INP(I_EVLNG) + c0), lg1 = *(const GAS f32x4*)(INP(I_EVLNG) + c0 + 4);
    f32x4 lb0 = *(const GAS f32x4*)(INP(I_EVLNB) + c0), lb1 = *(const GAS f32x4*)(INP(I_EVLNB) + c0 + 4);
    const int rpb = (MT + C.G - 1) / C.G, row0 = C.blk * rpb, row1 = (row0 + rpb < MT) ? row0 + rpb : MT;
    for (int row = row0 + C.wave; row < row1; row += 8) {
        int sb, l, L;
        if (row < MX) { sb = row & ~8191; l = row & 8191; L = SEQ; } else { sb = MX + ((row - MX) & ~255); l = (row - MX) & 255; L = CTX; }
        f32x4 a0 = bias0, a1 = bias1;
#pragma unroll 8
        for (int tap = 0; tap < 31; ++tap) {
            const int lp = l + tap - 15; const bool ok = lp >= 0 && lp < L; const int lc = ok ? lp : l;
            const u32x4 u = *(const GAS u32x4*)(UG + (size_t)(sb + lc) * 512 + c0);
            const float z = ok ? 1.0f : 0.0f;
            const f32x4 w0 = *(const LAS f32x4*)(cw + tap * 512 + c0) * z, w1 = *(const LAS f32x4*)(cw + tap * 512 + c0 + 4) * z;
            a0 += w0 * (f32x4){bflo(u.x), bfhi(u.x), bflo(u.y), bfhi(u.y)};
            a1 += w1 * (f32x4){bflo(u.z), bfhi(u.z), bflo(u.w), bfhi(u.w)};
        }
        const float mean = wave_sum((a0[0] + a0[1]) + (a0[2] + a0[3]) + (a1[0] + a1[1]) + (a1[2] + a1[3])) * (1.0f / 512.0f);
        a0 -= mean; a1 -= mean;
        const float var = wave_sum((a0[0] * a0[0] + a0[1] * a0[1]) + (a0[2] * a0[2] + a0[3] * a0[3]) + (a1[0] * a1[0] + a1[1] * a1[1]) + (a1[2] * a1[2] + a1[3] * a1[3])) * (1.0f / 512.0f);
        const float r = rsqrtf(var + EPS);
        a0 = a0 * r * lg0 + lb0; a1 = a1 * r * lg1 + lb1;
        u32x4 o; o.x = pk2(silu(a0[0]), silu(a0[1])); o.y = pk2(silu(a0[2]), silu(a0[3])); o.z = pk2(silu(a1[0]), silu(a1[1])); o.w = pk2(silu(a1[2]), silu(a1[3]));
        *(GAS u32x4*)(MIX + (size_t)row * 1024 + 512 + c0) = o;
    }
    __syncthreads();
}

DI int crow(int reg, int h) { return (reg & 3) + 8 * (reg >> 2) + 4 * h; }
DI void glds16(const GAS uchar* g, LAS uchar* l) { __builtin_amdgcn_global_load_lds((const GAS unsigned*)g, (LAS unsigned*)l, 16, 0, 0); }
template <int DVB, bool MASK, bool KW16>
DI void attn_tile(const LAS uchar* Kb, int kc0, const LAS uchar* Vb, const bf16x8 (&qf)[4], f32x16 (&O)[DVB], float& m, f32x16& negm, float& l, int r, int hh, int tq, int tk0, bool force) {
    constexpr int RB = KW16 ? 256 : 128;
    const int ksw = KW16 ? (r & 15) : ((r >> 1) & 7), vsw = (r >> 1) & 7;
    const LAS uchar* kp = Kb + r * RB;
    const LAS uchar* vp = Vb + r * 128;
    bf16x8 kf[2][4];
#pragma unroll
    for (int kb = 0; kb < 2; ++kb)
#pragma unroll
        for (int s = 0; s < 4; ++s) kf[kb][s] = *(const LAS bf16x8*)(kp + kb * 32 * RB + (((kc0 + 2 * s + hh) ^ ksw) * 16));
    f32x16 S[2];
    __builtin_amdgcn_s_setprio(1);
#pragma unroll
    for (int kb = 0; kb < 2; ++kb) S[kb] = MFMA32(kf[kb][0], qf[0], negm);
#pragma unroll
    for (int s = 1; s < 4; ++s)
#pragma unroll
        for (int kb = 0; kb < 2; ++kb) S[kb] = MFMA32(kf[kb][s], qf[s], S[kb]);
    __builtin_amdgcn_s_setprio(0);
    bf16x8 vf[2][DVB];
#pragma unroll
    for (int d = 0; d < DVB; ++d) vf[0][d] = *(const LAS bf16x8*)(vp + d * 32 * 128 + ((hh ^ vsw) * 16));
    float mx = -3.0e38f;
#pragma unroll
    for (int kb = 0; kb < 2; ++kb)
#pragma unroll
        for (int i = 0; i < 16; ++i) { float t = S[kb][i];
            if (MASK) { const int dk = tk0 + 32 * kb + crow(i, hh) - tq; t = (dk <= 128 && dk >= -128) ? t : -1e30f; S[kb][i] = t; }
            mx = fmaxf(mx, t); }
    if (force || __builtin_amdgcn_ballot_w64(mx > 8.0f) != 0ull) {
        mx = fmaxf(mx, __shfl_xor(mx, 32));
        const float delta = force ? mx : fmaxf(mx, 0.f);
        const float alpha = __builtin_amdgcn_exp2f(-delta);
        m += delta; l *= alpha;
#pragma unroll
        for (int i = 0; i < 16; ++i) negm[i] = -m;
#pragma unroll
        for (int d = 0; d < DVB; ++d) O[d] *= alpha;
#pragma unroll
        for (int kb = 0; kb < 2; ++kb)
#pragma unroll
            for (int i = 0; i < 16; ++i) S[kb][i] -= delta;
    }
    const bf16x2_t ones = __builtin_bit_cast(bf16x2_t, 0x3f803f80u);
#pragma unroll
    for (int step = 0; step < 4; ++step) {
        const int kb = step >> 1, s2 = step & 1;
        if (step < 3) {
#pragma unroll
            for (int d = 0; d < DVB; ++d) vf[(step + 1) & 1][d] = *(const LAS bf16x8*)(vp + d * 32 * 128 + (((2 * (step + 1) + hh) ^ vsw) * 16));
        }
        u32x4 pw;
        pw.x = pk2(__builtin_amdgcn_exp2f(S[kb][8 * s2 + 0]), __builtin_amdgcn_exp2f(S[kb][8 * s2 + 1])); pw.y = pk2(__builtin_amdgcn_exp2f(S[kb][8 * s2 + 2]), __builtin_amdgcn_exp2f(S[kb][8 * s2 + 3]));
        pw.z = pk2(__builtin_amdgcn_exp2f(S[kb][8 * s2 + 4]), __builtin_amdgcn_exp2f(S[kb][8 * s2 + 5])); pw.w = pk2(__builtin_amdgcn_exp2f(S[kb][8 * s2 + 6]), __builtin_amdgcn_exp2f(S[kb][8 * s2 + 7]));
        l += (bflo(pw.x) + bfhi(pw.x)) + (bflo(pw.y) + bfhi(pw.y)) + (bflo(pw.z) + bfhi(pw.z)) + (bflo(pw.w) + bfhi(pw.w));
        const bf16x8 pf = __builtin_bit_cast(bf16x8, pw);
#pragma unroll
        for (int d = 0; d < DVB; ++d) O[d] = MFMA32(vf[step & 1][d], pf, O[d]);
    }
    __builtin_amdgcn_sched_group_barrier(0x002, 20, 0);
#pragma unroll
    for (int st = 0; st < 3; ++st) {
        __builtin_amdgcn_sched_group_barrier(0x100, DVB, 0);
#pragma unroll
        for (int d = 0; d < DVB; ++d) { __builtin_amdgcn_sched_group_barrier(0x008, 1, 0); __builtin_amdgcn_sched_group_barrier(0x002, (20 + DVB - 1) / DVB, 0); }
    }
    __builtin_amdgcn_sched_group_barrier(0x008, DVB, 0);
}

DI void qk_scores(const LAS uchar* Kb, int kc0, const bf16x8 (&qf)[4], f32x16 (&S)[2], int r, int hh) {
    const int ksw = r & 15; const LAS uchar* kp = Kb + r * 256;
#pragma unroll
    for (int kb = 0; kb < 2; ++kb) {
        bf16x8 kf[4];
#pragma unroll
        for (int s = 0; s < 4; ++s) kf[s] = *(const LAS bf16x8*)(kp + kb * 32 * 256 + (((kc0 + 2 * s + hh) ^ ksw) * 16));
        { const f32x16 zero16 = {0.f, 0.f, 0.f, 0.f, 0.f, 0.f, 0.f, 0.f, 0.f, 0.f, 0.f, 0.f, 0.f, 0.f, 0.f, 0.f}; S[kb] = MFMA32(kf[0], qf[0], zero16); }
#pragma unroll
        for (int s = 1; s < 4; ++s) S[kb] = MFMA32(kf[s], qf[s], S[kb]);
    }
}
template <bool HASNEXT>
DI void attn_tile_pipe(const LAS uchar* Kn, int kc0, const LAS uchar* Vb, const bf16x8 (&qf)[4], f32x16 (&O)[4], f32x16 (&S)[2], f32x16 (&Sn)[2], float& m, float& l, int r, int hh, bool force) {
    constexpr int DVB = 4;
    const int ksw = r & 15, vsw = (r >> 1) & 7;
    const LAS uchar* vp = Vb + r * 128;
    const LAS uchar* kp = Kn + r * 256;
    bf16x8 kf[4];
    if (HASNEXT) {
#pragma unroll
        for (int s = 0; s < 4; ++s) kf[s] = *(const LAS bf16x8*)(kp + (((kc0 + 2 * s + hh) ^ ksw) * 16)); }
    bf16x8 vf[DVB];
#pragma unroll
    for (int d = 0; d < DVB; ++d) vf[d] = *(const LAS bf16x8*)(vp + d * 32 * 128 + ((hh ^ vsw) * 16));
    float mx0 = S[0][0], mx1 = S[1][0];
#pragma unroll
    for (int i = 1; i < 16; ++i) { mx0 = fmaxf(mx0, S[0][i]); mx1 = fmaxf(mx1, S[1][i]); }
    float mx = fmaxf(mx0, mx1);
    if (force || __builtin_amdgcn_ballot_w64(mx > m + 8.0f) != 0ull) {
        mx = fmaxf(mx, __shfl_xor(mx, 32));
        const float mn = force ? mx : fmaxf(mx, m);
        const float alpha = __builtin_amdgcn_exp2f(m - mn);
        m = mn; l *= alpha;
#pragma unroll
        for (int d = 0; d < DVB; ++d) O[d] *= alpha;
    }
    const f32x16 zero16 = {0.f, 0.f, 0.f, 0.f, 0.f, 0.f, 0.f, 0.f, 0.f, 0.f, 0.f, 0.f, 0.f, 0.f, 0.f, 0.f};
    float la0 = 0.f;
    u32x4 pw;
#define ATT_P(step) do { const int kb_ = (step) >> 1, s2_ = (step) & 1; \
        { const float e0 = __builtin_amdgcn_exp2f(S[kb_][8 * s2_ + 0] - m), e1 = __builtin_amdgcn_exp2f(S[kb_][8 * s2_ + 1] - m), e2 = __builtin_amdgcn_exp2f(S[kb_][8 * s2_ + 2] - m), e3 = __builtin_amdgcn_exp2f(S[kb_][8 * s2_ + 3] - m); \
          la0 += e0; la0 += e1; la0 += e2; la0 += e3;        \
          pw.x = pk2(e0, e1); pw.y = pk2(e2, e3); } \
        { const float e4 = __builtin_amdgcn_exp2f(S[kb_][8 * s2_ + 4] - m), e5 = __builtin_amdgcn_exp2f(S[kb_][8 * s2_ + 5] - m), e6 = __builtin_amdgcn_exp2f(S[kb_][8 * s2_ + 6] - m), e7 = __builtin_amdgcn_exp2f(S[kb_][8 * s2_ + 7] - m); \
          la0 += e4; la0 += e5; la0 += e6; la0 += e7; \
          pw.z = pk2(e4, e5); pw.w = pk2(e6, e7); } } while (0)
    if (HASNEXT) {
        __builtin_amdgcn_sched_barrier(0);
        Sn[0] = MFMA32(kf[0], qf[0], zero16);
#pragma unroll
        for (int s = 1; s < 4; ++s) Sn[0] = MFMA32(kf[s], qf[s], Sn[0]);
        __builtin_amdgcn_sched_barrier(0);
#pragma unroll
        for (int s = 0; s < 4; ++s) kf[s] = *(const LAS bf16x8*)(kp + 32 * 256 + (((kc0 + 2 * s + hh) ^ ksw) * 16));
        __builtin_amdgcn_sched_barrier(0);
    }
    ATT_P(0);
    if (HASNEXT) {
        __builtin_amdgcn_sched_barrier(0);
        Sn[1] = MFMA32(kf[0], qf[0], zero16);
#pragma unroll
        for (int s = 1; s < 4; ++s) Sn[1] = MFMA32(kf[s], qf[s], Sn[1]);
    }
#pragma unroll
    for (int step = 0; step < 4; ++step) {
        const bf16x8 pf = __builtin_bit_cast(bf16x8, pw);
        __builtin_amdgcn_sched_barrier(0);
#pragma unroll
        for (int d = 0; d < DVB; ++d) O[d] = MFMA32(vf[d], pf, O[d]);
        __builtin_amdgcn_sched_barrier(0);
        if (step < 3) {
#pragma unroll
            for (int d = 0; d < DVB; ++d) vf[d] = *(const LAS bf16x8*)(vp + d * 32 * 128 + (((2 * (step + 1) + hh) ^ vsw) * 16));
            __builtin_amdgcn_sched_barrier(0);
            ATT_P(step + 1);
        }
    }
#undef ATT_P
    l += la0;
}

constexpr int DSUB = 32768, DBUF = 2 * DSUB;
constexpr int WBUF = 16384;
static_assert(2 * DBUF <= LDS_BYTES, "attention LDS");
#define ATT_WAIT_BAR() do { asm volatile("s_waitcnt vmcnt(0)" ::: "memory"); __syncthreads(); } while (0)

DI void phase_attn(const Ctx& C) {
    const int lane = C.lane, w = C.wave, r = lane & 31, hh = lane >> 5;
    const GAS bf16* QD = WSP(bf16, WS_QD); const GAS bf16* QW = WSP(bf16, WS_QW); const GAS uchar* DK = WSP(uchar, WS_DK); const GAS uchar* DVT = WSP(uchar, WS_DVT);
    const GAS uchar* WK = WSP(uchar, WS_WK); const GAS uchar* WVT = WSP(uchar, WS_WVT); GAS bf16* ATT = WSP(bf16, WS_H);
    float lam;
    { const GAS float* lv = INP(I_ODLAM); const float a = wave_sum(lv[lane] * lv[64 + lane]), b = wave_sum(lv[128 + lane] * lv[192 + lane]); lam = __expf(a) - __expf(b) + LAM_INIT; }
    {
    unsigned koffs[4], voffs[4]; int kl[4], vl[4];
#pragma unroll
    for (int i = 0; i < 4; ++i) { const int qi = w * 4 + i, st = qi >> 4, q = qi & 15;
        const int row = 4 * q + (lane >> 4), c = (lane & 15) ^ (row & 15);
        koffs[i] = (unsigned)((st * 64 + row) * 512) * 2u + c * 16; kl[i] = st * DSUB + q * 1024;
        const int rowv = 8 * q + (lane >> 3), cv = (lane & 7) ^ ((rowv >> 1) & 7);
        voffs[i] = (unsigned)(rowv * KV + st * 64) * 2u + cv * 16; vl[i] = st * DSUB + 16384 + q * 1024; }
    const int nrounds_d = (1024 + C.G - 1) / C.G;
    for (int it = 0; it < nrounds_d; ++it) {
        int unit;
        if (C.G == 256) { const int x = C.blk & 7, cix = C.blk >> 3; unit = (x + 8 * (it >> 1)) * 64 + (it & 1) * 32 + cix; } else unit = it * C.G + C.blk;
        if (unit >= 1024) break;
        const int b = unit >> 8, h = (unit >> 6) & 3, qblk = unit & 63, qb4 = w >> 1, sub = w & 1;
        const int qrow = b * SEQ + qblk * 128 + qb4 * 32 + r;
        bf16x8 qf[4];
#pragma unroll
        for (int s = 0; s < 4; ++s) qf[s] = *(const GAS bf16x8*)(QD + (size_t)qrow * 512 + h * 128 + sub * 64 + 16 * s + 8 * hh);
        f32x16 O[4];
#pragma unroll
        for (int d = 0; d < 4; ++d)
#pragma unroll
            for (int i = 0; i < 16; ++i) O[d][i] = 0.f;
        float m = 0.f, l = 0.f; f32x16 negm;
#pragma unroll
        for (int i = 0; i < 16; ++i) negm[i] = 0.f;
        const GAS uchar* kbase = DK + ((size_t)b * KV * 512 + h * 128) * 2;
        const GAS uchar* vbase = DVT + ((size_t)(b * 512 + h * 128) * KV) * 2;
#define ATT_ISSUE(kt, Bn) do { const GAS uchar* kg_ = kbase + (size_t)(kt) * (128 * 512 * 2); const GAS uchar* vg_ = vbase + (kt) * 256; asm volatile("" : "+s"(kg_), "+s"(vg_)); \
            _Pragma("unroll") for (int i = 0; i < 4; ++i) { glds16(kg_ + koffs[i], (Bn) + kl[i]); glds16(vg_ + voffs[i], (Bn) + vl[i]); } } while (0)
        ATT_ISSUE(0, C.lds);
        ATT_WAIT_BAR();
        constexpr int NT = KV / 128;
        f32x16 Sc[2], Sx[2];
        qk_scores(C.lds, sub * 8, qf, Sc, r, hh);
#pragma unroll 1
        for (int kt = 0; kt < NT - 1; ++kt) {
            { LAS uchar* Bn = C.lds + ((kt + 1) & 1) * DBUF; ATT_ISSUE(kt + 1, Bn); }
            const LAS uchar* B = C.lds + (kt & 1) * DBUF;
            attn_tile_pipe<true>(B + DSUB, sub * 8, B + 16384, qf, O, Sc, Sx, m, l, r, hh, kt == 0);
            attn_tile_pipe<false>(B, sub * 8, B + DSUB + 16384, qf, O, Sx, Sc, m, l, r, hh, false);
            ATT_WAIT_BAR();
            qk_scores(C.lds + ((kt + 1) & 1) * DBUF, sub * 8, qf, Sc, r, hh);
        }
        { const LAS uchar* B = C.lds + ((NT - 1) & 1) * DBUF;
            attn_tile_pipe<true>(B + DSUB, sub * 8, B + 16384, qf, O, Sc, Sx, m, l, r, hh, false);
            attn_tile_pipe<false>(B, sub * 8, B + DSUB + 16384, qf, O, Sx, Sc, m, l, r, hh, false);
            ATT_WAIT_BAR(); }
#undef ATT_ISSUE
        const float inv = 1.0f / (l + __shfl_xor(l, 32));
        LAS float* ex = (LAS float*)C.lds + qb4 * 4096;
        if (sub == 1) {
#pragma unroll
            for (int d = 0; d < 4; ++d)
#pragma unroll
                for (int i = 0; i < 16; ++i) ex[(d * 16 + i) * 64 + lane] = O[d][i] * inv;
        }
        __syncthreads();
        if (sub == 0) {
            float ss = 0.f;
#pragma unroll
            for (int d = 0; d < 4; ++d)
#pragma unroll
                for (int i = 0; i < 16; ++i) { const float o = O[d][i] * inv - lam * ex[(d * 16 + i) * 64 + lane]; O[d][i] = o; ss += o * o; }
            ss += __shfl_xor(ss, 32);
            const float rn = rsqrtf(ss * (1.0f / 128.0f) + EPS) * (1.0f - LAM_INIT);
            GAS bf16* orow = ATT + (size_t)qrow * 1024 + h * 128;
#pragma unroll
            for (int d = 0; d < 4; ++d)
#pragma unroll
                for (int g4 = 0; g4 < 4; ++g4) { const int dv = 32 * d + 8 * g4 + 4 * hh; const f32x4 sg = *(const GAS f32x4*)(INP(I_ODSUBG) + dv);
                    u32x2 o2; o2.x = pk2(O[d][4 * g4] * rn * sg[0], O[d][4 * g4 + 1] * rn * sg[1]); o2.y = pk2(O[d][4 * g4 + 2] * rn * sg[2], O[d][4 * g4 + 3] * rn * sg[3]);
                    *(GAS u32x2*)(orow + dv) = o2; }
        }
        __syncthreads();
    }
    }
    {
    const int rowk = 8 * w + (lane >> 3), ck = (lane & 7) ^ ((rowk >> 1) & 7);
    const unsigned koff = (unsigned)(rowk * 128) * 2u + ck * 16, voff = (unsigned)(rowk * KV) * 2u + ck * 16;
    const int kl = w * 1024, vl = 8192 + w * 1024;
    const int nrounds_w = (1024 + C.G - 1) / C.G;
    for (int it = 0; it < nrounds_w; ++it) {
        int unit;
        if (C.G == 256) { const int x = C.blk & 7, cix = C.blk >> 3; unit = x * 128 + it * 32 + cix; } else unit = it * C.G + C.blk;
        if (unit >= 1024) break;
        const int b = unit >> 8, kvh = (unit >> 7) & 1, q0 = (unit & 127) * 64, g = w >> 1, qh = w & 1;
        const int tq = q0 + 32 * qh + r, qrow = b * SEQ + tq;
        bf16x8 qf[4];
#pragma unroll
        for (int s = 0; s < 4; ++s) qf[s] = *(const GAS bf16x8*)(QW + (size_t)qrow * 512 + kvh * 256 + g * 64 + 16 * s + 8 * hh);
        f32x16 O[2];
#pragma unroll
        for (int d = 0; d < 2; ++d)
#pragma unroll
            for (int i = 0; i < 16; ++i) O[d][i] = 0.f;
        float m = INP(I_ODSINK)[kvh * 4 + g] * LOG2E, l = hh == 0 ? 1.0f : 0.0f; f32x16 negm;
#pragma unroll
        for (int i = 0; i < 16; ++i) negm[i] = -m;
        const int jlo_w = (q0 - 128 < 0) ? 4 + (128 - q0) / 64 : 4;
        const int jhi_w = (q0 + 192 > SEQ) ? 9 - (q0 + 192 - SEQ) / 64 : 9;
        const int ntile = 4 + (jhi_w - jlo_w);
        const GAS uchar* kbase = WK + ((size_t)b * KV * 128 + kvh * 64) * 2;
        const GAS uchar* vbase = WVT + ((size_t)(b * 128 + kvh * 64) * KV) * 2;
#define WIN_P0(i) ((i) < 4 ? 64 * (i) : CTX + q0 - 128 + 64 * ((i) - 4 + jlo_w - 4))
#define WIN_ISSUE(i, Bn) do { const int p0_ = WIN_P0(i); const GAS uchar* kg_ = kbase + (size_t)p0_ * 256; const GAS uchar* vg_ = vbase + p0_ * 2; asm volatile("" : "+s"(kg_), "+s"(vg_)); glds16(kg_ + koff, (Bn) + kl); glds16(vg_ + voff, (Bn) + vl); } while (0)
        WIN_ISSUE(0, C.lds);
        ATT_WAIT_BAR();
#pragma unroll 1
        for (int i = 0; i < ntile; ++i) {
            if (i + 1 < ntile) { LAS uchar* Bn = C.lds + ((i + 1) & 1) * WBUF; WIN_ISSUE(i + 1, Bn); }
            const LAS uchar* B = C.lds + (i & 1) * WBUF;
            if (i >= 4) attn_tile<2, true, false>(B, 0, B + 8192, qf, O, m, negm, l, r, hh, tq, WIN_P0(i) - CTX, false);
            else attn_tile<2, false, false>(B, 0, B + 8192, qf, O, m, negm, l, r, hh, 0, 0, false);
            ATT_WAIT_BAR();
        }
#undef WIN_P0
#undef WIN_ISSUE
        const float inv = 1.0f / (l + __shfl_xor(l, 32));
        GAS bf16* orow = ATT + (size_t)qrow * 1024 + 512 + kvh * 256 + g * 64;
#pragma unroll
        for (int d = 0; d < 2; ++d)
#pragma unroll
            for (int g4 = 0; g4 < 4; ++g4) { const int dv = 32 * d + 8 * g4 + 4 * hh;
                u32x2 o2; o2.x = pk2(O[d][4 * g4] * inv, O[d][4 * g4 + 1] * inv); o2.y = pk2(O[d][4 * g4 + 2] * inv, O[d][4 * g4 + 3] * inv);
                *(GAS u32x2*)(orow + dv) = o2; }
    }
    }
    __syncthreads();
}
constexpr int N_PHASES = 25;
#define XB_TMO      128
#define XB_XCNT(j)  (256  + 64 * (j))
#define XB_XSUB(j)  (1280 + 64 * (j))
#define XB_XGEN(j)  (2304 + 64 * (j))
#define XB_TOP      3328
#define XB_TOPGEN   3392
#define XCD_BAR_WORDS 3456
#define XB_SPIN_CAP (1u << 18)

__device__ __forceinline__ unsigned xb_ld(unsigned* p)              { return __hip_atomic_load(p, __ATOMIC_RELAXED, __HIP_MEMORY_SCOPE_AGENT); }
__device__ __forceinline__ unsigned xb_add(unsigned* p, unsigned v) { return __hip_atomic_fetch_add(p, v, __ATOMIC_RELAXED, __HIP_MEMORY_SCOPE_AGENT); }
__device__ __forceinline__ unsigned xb_xcc_id() { return (unsigned)__builtin_amdgcn_s_getreg((3 << 11) | 20) & 0xFu; }
#define XB_SPIN(cond, bar) do { unsigned _sp = 0; while (cond) { __builtin_amdgcn_s_sleep(1); \
    if ((++_sp & 255u) == 0u) { if (xb_ld(&(bar)[XB_TMO])) break; if (_sp > XB_SPIN_CAP) { atomicAdd(&(bar)[XB_TMO], 1u); break; } } } } while (0)

struct XcdBarrier {
    unsigned* bar; unsigned x;
    volatile LAS unsigned* st;
};

__device__ __forceinline__ XcdBarrier xcd_barrier_post(unsigned* bar, volatile LAS unsigned* st) {
    XcdBarrier b; b.bar = bar; b.x = xb_xcc_id(); b.st = st;
    if (threadIdx.x == 0) (void)xb_add(&bar[XB_XCNT(b.x)], 1u);
    return b;
}
__device__ __forceinline__ void xcd_barrier_complete(unsigned* bar, unsigned x, unsigned& nloc, unsigned& nx) {
    const unsigned G = gridDim.x * gridDim.y * gridDim.z;
    unsigned sum, cnt, mine, sp = 0u;
    for (;;) {
        sum = 0u; cnt = 0u; mine = 0u;
#pragma unroll
        for (unsigned j = 0; j < 16; ++j) { const unsigned c = xb_ld(&bar[XB_XCNT(j)]); sum += c; cnt += (c > 0u) ? 1u : 0u; mine = (j == x) ? c : mine; }
        if (sum == G) break;
        __builtin_amdgcn_s_sleep(1);
        if ((++sp & 255u) == 0u) { if (xb_ld(&bar[XB_TMO])) break; if (sp > XB_SPIN_CAP) { atomicAdd(&bar[XB_TMO], 1u); break; } }
    }
    nloc = mine > 0u ? mine : 1u; nx = cnt > 0u ? cnt : 1u;
}

__device__ __forceinline__ void xcd_barrier(const XcdBarrier& b) {
    asm volatile("s_waitcnt vmcnt(0)" ::: "memory");
    __syncthreads();
    if (threadIdx.x == 0) {
        unsigned* bar = b.bar;
        __builtin_amdgcn_s_waitcnt(0);
        unsigned nloc = b.st[0], nx = b.st[1];
        if (nloc == 0u) { xcd_barrier_complete(bar, b.x, nloc, nx); b.st[0] = nloc; b.st[1] = nx; }
        const unsigned old = xb_add(&bar[XB_XSUB(b.x)], 1u);
        const unsigned gen = old / nloc;
        if (old + 1u == (gen + 1u) * nloc) {
            __builtin_amdgcn_fence(__ATOMIC_RELEASE, "agent");
            asm volatile("s_waitcnt vmcnt(0)" ::: "memory");
            const unsigned og = xb_add(&bar[XB_TOP], 1u);
            const unsigned tg = og / nx;
            if (og + 1u == (tg + 1u) * nx) xb_add(&bar[XB_TOPGEN], 1u);
            else XB_SPIN(xb_ld(&bar[XB_TOPGEN]) == tg, bar);
            __builtin_amdgcn_fence(__ATOMIC_ACQUIRE, "agent");
            xb_add(&bar[XB_XGEN(b.x)], 1u);
            asm volatile("s_waitcnt vmcnt(0)" ::: "memory");
        } else {
            XB_SPIN(xb_ld(&bar[XB_XGEN(b.x)]) == gen, bar);
            __builtin_amdgcn_fence(__ATOMIC_ACQUIRE, "agent");
            asm volatile("s_waitcnt vmcnt(0)" ::: "memory");
        }
    }
    __syncthreads();
}

namespace pg8 {
struct Order2 : StaticOrder {
    int nsplit, nMs, nNs;
    __device__ void init2(int M, int N, int G_, int c_, int nsplit_) { init(M, N, G_, c_); nsplit = nsplit_; nMs = M / BM; nNs = N / BM; }
    __device__ __forceinline__ bool next(int i, Unit& u) const {
        int pm = 0, pn = 0, ks = 0; bool ok;
        if (nsplit <= 1) { Unit t; t.pm = 0; t.pn = 0; t.ks = 0; ok = StaticOrder::next(i, t); pm = t.pm; pn = t.pn; }
        else { const int idx = i * G + c, per = nMs * nNs; ok = idx < per * nsplit; ks = idx / per; const int rem = idx % per; pm = rem % nMs; pn = rem / nMs; }
        u.pm = pm; u.pn = pn; u.ks = ks; return ok;
    }
};
}
DI unsigned long long uniform_ptr(unsigned long long v) { const unsigned lo = __builtin_amdgcn_readfirstlane((unsigned)v), hi = __builtin_amdgcn_readfirstlane((unsigned)(v >> 32)); return ((unsigned long long)hi << 32) | lo; }
#ifndef MK_ONE_LAUNCH
#define MK_ONE_LAUNCH 1
#endif

template <int ph> DI void run_phase(const Ctx& C) {
    using namespace pg8;
    GAS float* xout = (GAS float*)C.out; GAS float* cres = WSP(float, WS_CTXR);
    switch (ph) {
    case 0: phase_prep(C); break;
    case 1: phase_modred(C); break;
    case 2: phase_e(C, 0, 0, 0, 0, 0.f, 1, 0, 0, MT, INP(I_X), INP(I_CTX), nullptr, nullptr, false, false); break;
    case 5: phase_e(C, 11, 1, 0, 0, 0.5f, 1, 0, 1, MT, INP(I_X), INP(I_CTX), xout, cres, false, true); phase_dftm(C); break;
    case 10: phase_e(C, 4, 1, 0, 1, 1.0f, 1, 0, 2, MT, xout, cres, xout, cres, true, true); break;
    case 13: phase_e(C, 11, 1, 0, 2, 0.5f, 1, 1, 0, MT, xout, cres, xout, cres, true, true); break;
    case 16: phase_e(C, 11, 1, 1, 0, 0.5f, 1, 1, 1, MT, xout, cres, xout, cres, true, true); break;
    case 20: phase_e(C, 0, 1, 1, 1, 1.0f, 1, 1, 2, MX, xout, cres, WSP(float, WS_XF), cres, true, true); break;
    case 23: phase_e(C, 0, 1, 1, 2, 0.5f, 0, 0, 0, MX, WSP(float, WS_XF), cres, xout, cres, true, false); break;
    case 3: case 11: case 14: case 21: {
        const int idx = ph == 3 ? 0 : ph == 11 ? 1 : ph == 14 ? 2 : 3, M = ph == 21 ? MX : MT;
        Gemm g{(bf16_t*)WSP(bf16_t, WS_H), (bf16_t*)WSP(bf16_t, WS_W1T) + (size_t)idx * W1T_SZ, M, 2 * DFF, DM, DM}; StaticOrder S; S.init(M, 2 * DFF, C.G, C.blk);
        EpiSwiGLU E{WSP(bf16_t, WS_ACT)};
        gemm_phase<EpiSwiGLU, StaticOrder, true, true>(C.lds, g, S, E);
    } break;
    case 4: case 12: case 15: case 22: case 9: case 19: case 8: {
        const int nrep = (ph == 19 || ph == 22) ? 1 : 2;
#pragma unroll 1
        for (int rep = 0; rep < nrep; ++rep) {
            const bf16_t* A; const bf16_t* Bt; int M = MX, N = DM, K = DM, ld = DM, nsplit = 1;
            GAS bf16_t* O = WSP(bf16_t, WS_Y); float sc = 1.0f; int dft = 0, L = 0, rowbase = 0, slab = 0, ldc = DM;
            if (ph == 9) { A = (bf16_t*)WSP(bf16_t, WS_H); Bt = (bf16_t*)WSP(bf16_t, WS_WEVOUT); }
            else if (ph == 19) { A = (bf16_t*)WSP(bf16_t, WS_H); Bt = (bf16_t*)WSP(bf16_t, WS_WODOUT); }
            else if (ph == 8) { A = (bf16_t*)WSP(bf16_t, WS_DFTM); Bt = (bf16_t*)WSP(bf16_t, WS_BDFT); M = 4096; N = 2048; K = 4096; ld = SEQ; nsplit = 2; O = WSP(bf16_t, WS_DS); ldc = 2048; slab = 4096 * 2048; }
            else { const int idx = ph == 4 ? 0 : ph == 12 ? 1 : ph == 15 ? 2 : 3; A = (bf16_t*)WSP(bf16_t, WS_ACT); Bt = (bf16_t*)WSP(bf16_t, WS_W2T) + (size_t)idx * W2T_SZ; K = DFF; ld = DFF; }
            if (rep == 1) {
                if (ph == 8) { A = (bf16_t*)WSP(bf16_t, WS_DFTC); Bt = (bf16_t*)WSP(bf16_t, WS_BDFTC); M = CTX; K = CTX; ld = CTX; nsplit = 1; O = WSP(bf16_t, WS_H); ldc = DM; slab = 0; sc = 0.005524271728019903f; dft = 1; L = CTX; rowbase = MX; }
                else { A += (size_t)MX * ld; M = MC; nsplit = ld / 256; K = 256; O = WSP(bf16_t, WS_YS); slab = MC * DM; }
            }
            const EpiY E{O, ldc, sc, dft, L, rowbase, slab};
            const Gemm g{A, Bt, M, N, K, ld}; Order2 S; S.init2(M, N, C.G, C.blk, nsplit);
            gemm_phase<EpiY, Order2, true, true>(C.lds, g, S, E);
        }
    } break;
    case 6: {
        Gemm g{(bf16_t*)WSP(bf16_t, WS_H), (bf16_t*)WSP(bf16_t, WS_WEVIN), MT, 2048, DM, DM}; StaticOrder S; S.init(MT, 2048, C.G, C.blk);
        EpiEvIn E{WSP(bf16_t, WS_PQ), WSP(bf16_t, WS_UG)};
        gemm_phase<EpiEvIn, StaticOrder, true, true>(C.lds, g, S, E);
    } break;
    case 7: fold_tiles(C, WSP(bf16, WS_PQ), 0, SEQ, WSP(bf16, WS_BDFT), true); fold_tiles(C, WSP(bf16, WS_PQ), MX, CTX, WSP(bf16, WS_BDFTC), false); altsum_partials(C); phase_conv(C); break;
    case 24: phase_unfold(C); break;
    case 17: {
        Gemm g{(bf16_t*)WSP(bf16_t, WS_H), (bf16_t*)WSP(bf16_t, WS_WODIN), MT, 2304, DM, DM}; StaticOrder S; S.init(MT, 2304, C.G, C.blk);
        EpiOdIn E{WSP(bf16_t, WS_QD), WSP(bf16_t, WS_QW), WSP(bf16_t, WS_DK), WSP(bf16_t, WS_DVT), WSP(bf16_t, WS_WK), WSP(bf16_t, WS_WVT), WSP(const f32x2_t, WS_ROPE)};
        gemm_phase<EpiOdIn, StaticOrder, true, true>(C.lds, g, S, E);
    } break;
    case 18: phase_attn(C); break;
    default: break;
    }
}

__global__ void __launch_bounds__(512, 2) fwd_kernel(Args a) {
    extern __shared__ __attribute__((aligned(16))) unsigned char lds_raw[];
    Ctx C;
    C.lds = (LAS uchar*)lds_raw; C.tid = threadIdx.x; C.lane = C.tid & 63; C.wave = __builtin_amdgcn_readfirstlane(C.tid >> 6);
    C.G = gridDim.x; C.blk = blockIdx.x; C.in = a.in; C.out = a.out; C.ws = a.ws;
    const int lo_ = a.ph_lo, hi_ = a.ph_hi;
    volatile LAS unsigned* bar_st = (volatile LAS unsigned*)((LAS uchar*)lds_raw + 131072 + 352);
    if (threadIdx.x < 2) bar_st[threadIdx.x] = 0u;
    __syncthreads();
    const XcdBarrier xbar = xcd_barrier_post((unsigned*)a.ws, bar_st);
#define PHASE(k, dosync) if (lo_ <= (k) && (k) < hi_) { \
        { int t = threadIdx.x, g = gridDim.x, bk = blockIdx.x; unsigned char* w = a.ws; float* o = a.out; unsigned lo = 0; \
          asm volatile("" : "+v"(t), "+s"(g), "+s"(bk), "+s"(w), "+s"(o), "+s"(lo)); \
          C.tid = t; C.lane = t & 63; C.wave = __builtin_amdgcn_readfirstlane(t >> 6); C.G = __builtin_amdgcn_readfirstlane(g); C.blk = __builtin_amdgcn_readfirstlane(bk); \
          C.ws = (unsigned char*)uniform_ptr((unsigned long long)w); C.out = (float*)uniform_ptr((unsigned long long)o); C.lds = (LAS uchar*)lds_raw + __builtin_amdgcn_readfirstlane(lo); } \
        run_phase<k>(C); __syncthreads(); if ((dosync) == 2) cg::this_grid().sync(); else if ((dosync) == 1) xcd_barrier(xbar); }
    PHASE(0, 1) PHASE(1, 1) PHASE(2, 1) PHASE(3, 1) PHASE(4, 1) PHASE(5, 1) PHASE(6, 1) PHASE(7, 1) PHASE(8, 1) PHASE(24, 1) PHASE(9, 1) PHASE(10, 1) PHASE(11, 1)
    PHASE(12, 1) PHASE(13, 1) PHASE(14, 1) PHASE(15, 1) PHASE(16, 1) PHASE(17, 1) PHASE(18, 1) PHASE(19, 1) PHASE(20, 1) PHASE(21, 1) PHASE(22, 1) PHASE(23, 0)
#undef PHASE
    if (a.ph_hi < 0) cg::this_grid().sync();
}

extern "C" void kernel_launch(void* const* d_in, const int* in_sizes, int n_in, void* d_out, int out_size, void* d_ws, size_t ws_size, hipStream_t stream) {
    static int grid = 0;
    if (grid == 0) {
        int dev = 0, cus = 0, per_cu = 0;
        if (hipGetDevice(&dev) != hipSuccess || hipDeviceGetAttribute(&cus, hipDeviceAttributeMultiprocessorCount, dev) != hipSuccess) { fprintf(stderr, "kernel_launch: device query failed\n"); grid = -1; return; }
        if (hipFuncSetAttribute((const void*)fwd_kernel, hipFuncAttributeMaxDynamicSharedMemorySize, LDS_BYTES) != hipSuccess) { fprintf(stderr, "kernel_launch: hipFuncSetAttribute failed\n"); grid = -1; return; }
        if (hipOccupancyMaxActiveBlocksPerMultiprocessor(&per_cu, (const void*)fwd_kernel, 512, LDS_BYTES) != hipSuccess || per_cu < 1) { fprintf(stderr, "kernel_launch: occupancy query says %d\n", per_cu); per_cu = 1; }
        (void)hipGetLastError();
        grid = cus;
        if (n_in != 21 || ws_size < WS_END) fprintf(stderr, "kernel_launch: unexpected n_in %d / ws_size %zu\n", n_in, ws_size);
    }
    if (grid < 0) return;
    if (hipMemsetAsync(d_ws, 0, 16384, stream) != hipSuccess) { fprintf(stderr, "kernel_launch: memset of the barrier words failed\n"); return; }
    Args a{};
    for (int i = 0; i < 21; ++i) a.in[i] = (const float*)d_in[i];
    a.out = (float*)d_out; a.ws = (unsigned char*)d_ws;
#if MK_ONE_LAUNCH
    a.ph_lo = 0; a.ph_hi = N_PHASES;
    void* args[] = {&a};
    hipError_t e = hipLaunchCooperativeKernel((const void*)fwd_kernel, dim3(grid), dim3(512), args, LDS_BYTES, stream);
    if (e != hipSuccess) fprintf(stderr, "cooperative launch failed: %s (grid %d)\n", hipGetErrorString(e), grid);
#else
    for (int ph = 0; ph < N_PHASES; ++ph) { a.ph_lo = ph; a.ph_hi = ph + 1; hipLaunchKernelGGL(fwd_kernel, dim3(grid), dim3(512), LDS_BYTES, stream, a); }
#endif
}
```
